# Optimizing an MI355X kernel written in HIP

```python
import jax, jax.numpy as jnp
from jax import lax
import numpy as np

D_MODEL = 1024
BATCH = 16
SEQ = 256
DEPTH = 2
DEC_BATCH = 4
DEC_SEQ = 1024
PAST_LEN = 512

GRID_W = 64
MIX_WIDTH = 1024
MLA_HEADS = 4
NOPE_DIM = 128
ROPE_DIM = 64
V_DIM = 128
QK_DIM = NOPE_DIM + ROPE_DIM
MLA_WIDTH = MLA_HEADS * V_DIM
Q_LORA = 384
KV_LORA = 256
POOL_GROUPS = 4
POOL_GROUP_DIM = 64
POOL_WIDTH = POOL_GROUPS * POOL_GROUP_DIM
POOL_WINDOWS = (2, 4, 8, 16)
CONV_WIDTH = 256
CONV_K = 3
IN_SPLITS = (Q_LORA, KV_LORA, ROPE_DIM, MLA_WIDTH, POOL_WIDTH, POOL_WIDTH,
             CONV_WIDTH, CONV_WIDTH, CONV_WIDTH, CONV_WIDTH)
IN_WIDTH = sum(IN_SPLITS)
ROPE_BASE = 10000.0
AXIS_DIM = ROPE_DIM // 2
Q_BLOCK = 128
ATTN_SCALE = QK_DIM ** -0.5
EPS = 1e-6

kernel_name = "hybrid_mla_pool_conv_diffusion_step"


def rmsnorm(x, g):
    x32 = x.astype(jnp.float32)
    y = x32 * lax.rsqrt(jnp.mean(x32 * x32, axis=-1, keepdims=True) + EPS)
    return (y * g.astype(jnp.float32)).astype(x.dtype)


def axial_rope(L):
    rows = L // GRID_W
    row = jnp.repeat(jnp.arange(rows), GRID_W).astype(jnp.float32)
    col = jnp.tile(jnp.arange(GRID_W), rows).astype(jnp.float32)
    inv = 1.0 / (ROPE_BASE ** (jnp.arange(0, AXIS_DIM, 2, dtype=jnp.float32) / AXIS_DIM))
    ang = jnp.concatenate([row[:, None] * inv, col[:, None] * inv], axis=-1)
    return jnp.cos(ang), jnp.sin(ang)


def apply_rope(x, cos, sin):
    x32 = x.astype(jnp.float32)
    x1, x2 = x32[..., :AXIS_DIM], x32[..., AXIS_DIM:]
    return jnp.concatenate([x1 * cos - x2 * sin, x2 * cos + x1 * sin], axis=-1).astype(x.dtype)


def mla_attention(q_nope, q_rope, k_nope, k_rope, v):
    B, Lq, H, _ = q_nope.shape
    nb = Lq // Q_BLOCK

    def blocks(a):
        return jnp.moveaxis(a.reshape((B, nb, Q_BLOCK) + a.shape[2:]), 1, 0)

    def one(args):
        qn, qr = args
        s = (jnp.einsum('bqhd,bkhd->bhqk', qn, k_nope)
             + jnp.einsum('bqhr,bkr->bhqk', qr, k_rope)).astype(jnp.float32) * ATTN_SCALE
        p = jax.nn.softmax(s, axis=-1).astype(v.dtype)
        return jnp.einsum('bhqk,bkhd->bqhd', p, v)

    out = lax.map(one, (blocks(q_nope), blocks(q_rope)))
    return jnp.moveaxis(out, 0, 1).reshape(B, Lq, H * V_DIM)


def pool_mix(p, pool_w, pool_s):
    B, L, _ = p.shape
    cs = jnp.concatenate([jnp.zeros((B, 1, POOL_WIDTH), jnp.float32),
                          jnp.cumsum(p.astype(jnp.float32), axis=1)], axis=1)
    t = np.arange(L)
    outs = []
    for gi, w in enumerate(POOL_WINDOWS):
        lo = np.maximum(t - w // 2, 0)
        hi = np.minimum(t + (w - w // 2), L)
        cnt = (hi - lo).astype(np.float32)
        csg = cs[..., gi * POOL_GROUP_DIM:(gi + 1) * POOL_GROUP_DIM]
        outs.append((csg[:, hi] - csg[:, lo]) / cnt[None, :, None])
    pooled = (jnp.stack(outs, axis=2).astype(p.dtype)
              - p.reshape(B, L, POOL_GROUPS, POOL_GROUP_DIM))
    y = jnp.einsum('btgc,gcd->btgd', pooled, pool_w).reshape(B, L, POOL_WIDTH)
    return y * pool_s


def short_conv(z, conv_w):
    zp = jnp.pad(z, ((0, 0), (1, 1), (0, 0)))
    return zp[:, :-2] * conv_w[0] + zp[:, 1:-1] * conv_w[1] + zp[:, 2:] * conv_w[2]


def mixer_layer(x, mod, g_norm, w_in, g_q, w_uq, g_kv, w_ukv, pool_w, pool_s, conv_w, w_out,
                ctx=None, rope=None):
    B, L, _ = x.shape
    shift, scale, gate = jnp.split(mod, 3, axis=-1)
    h = rmsnorm(x, g_norm) * (1.0 + scale[:, None]) + shift[:, None]
    u = h @ w_in
    offs = [int(o) for o in np.cumsum(IN_SPLITS)[:-1]]
    cq, ckv_raw, kr, g_mla, px, g_pool, cb, cc, ch, g_conv = jnp.split(u, offs, axis=-1)

    q = (rmsnorm(cq, g_q) @ w_uq).reshape(B, L, MLA_HEADS, QK_DIM)
    q_nope, q_rope = q[..., :NOPE_DIM], q[..., NOPE_DIM:]
    ckv = rmsnorm(ckv_raw, g_kv)
    if rope is not None:
        cos, sin = rope
        q_rope = apply_rope(q_rope, cos[:, None], sin[:, None])
        kr = apply_rope(kr, cos, sin)
    if ctx is None:
        ckv_all, kr_all = ckv, kr
    else:
        ckv_all = jnp.concatenate([ctx[0], ckv], axis=1)
        kr_all = jnp.concatenate([ctx[1], kr], axis=1)
    kv = (ckv_all @ w_ukv).reshape(B, ckv_all.shape[1], MLA_HEADS, NOPE_DIM + V_DIM)
    k_nope, v = kv[..., :NOPE_DIM], kv[..., NOPE_DIM:]
    attn = mla_attention(q_nope, q_rope, k_nope, kr_all, v)

    pool = pool_mix(px, pool_w, pool_s)

    conv = cb * short_conv(cc * ch, conv_w)

    mixed = jnp.concatenate([jax.nn.silu(g_mla) * attn,
                             jax.nn.silu(g_pool) * pool,
                             jax.nn.silu(g_conv) * conv], axis=-1)
    y = x + gate[:, None] * (mixed @ w_out)
    return y, ckv, kr


def setup_inputs(seed: int = 0) -> dict:
    key = jax.random.key(seed)
    ks = jax.random.split(key, 24)
    f32 = jnp.float32
    nrm = lambda k, s, sc: jax.random.normal(k, s, f32) * sc
    gain = lambda k, s: 1.0 + 0.1 * jax.random.normal(k, s, f32)
    return {
        "x_prompt": nrm(ks[0], (BATCH, SEQ, D_MODEL), 1.0),
        "x_sample": nrm(ks[1], (DEC_BATCH, DEC_SEQ, D_MODEL), 1.0),
        "cache_ckv": nrm(ks[2], (DEC_BATCH, DEPTH, PAST_LEN, KV_LORA), 1.0),
        "cache_krope": nrm(ks[3], (DEC_BATCH, DEPTH, PAST_LEN, ROPE_DIM), 1.0),
        "c": nrm(ks[4], (DEC_BATCH, D_MODEL), 1.0),
        "c_ctx": nrm(ks[5], (D_MODEL,), 1.0),
        "w_mod": nrm(ks[6], (DEPTH, D_MODEL, 3 * D_MODEL), 0.5 * D_MODEL ** -0.5),
        "b_mod": nrm(ks[7], (DEPTH, 3 * D_MODEL), 0.02),
        "g_norm": gain(ks[8], (DEPTH, D_MODEL)),
        "w_in": nrm(ks[9], (DEPTH, D_MODEL, IN_WIDTH), D_MODEL ** -0.5),
        "g_q": gain(ks[10], (DEPTH, Q_LORA)),
        "w_uq": nrm(ks[11], (DEPTH, Q_LORA, MLA_HEADS * QK_DIM), Q_LORA ** -0.5),
        "g_kv": gain(ks[12], (DEPTH, KV_LORA)),
        "w_ukv": nrm(ks[13], (DEPTH, KV_LORA, MLA_HEADS * (NOPE_DIM + V_DIM)), KV_LORA ** -0.5),
        "pool_w": nrm(ks[14], (DEPTH, POOL_GROUPS, POOL_GROUP_DIM, POOL_GROUP_DIM), POOL_GROUP_DIM ** -0.5),
        "pool_s": gain(ks[15], (DEPTH, POOL_WIDTH)),
        "conv_w": nrm(ks[16], (DEPTH, CONV_K, CONV_WIDTH), CONV_K ** -0.5),
        "w_out": nrm(ks[17], (DEPTH, MIX_WIDTH, D_MODEL), MIX_WIDTH ** -0.5),
        "g_final": gain(ks[18], (D_MODEL,)),
    }


def reference(x_prompt, x_sample, cache_ckv, cache_krope, c, c_ctx, w_mod, b_mod, g_norm, w_in,
              g_q, w_uq, g_kv, w_ukv, pool_w, pool_s, conv_w, w_out, g_final):
    xp = x_prompt
    ckv_states, kr_states = [], []
    for l in range(DEPTH):
        mod_ctx = (jax.nn.silu(c_ctx)[None] @ w_mod[l] + b_mod[l])
        xp, ckv, kr = mixer_layer(xp, mod_ctx, g_norm[l], w_in[l], g_q[l], w_uq[l], g_kv[l], w_ukv[l],
                                  pool_w[l], pool_s[l], conv_w[l], w_out[l])
        ckv_states.append(ckv)
        kr_states.append(kr)
    y_prompt = rmsnorm(xp, g_final)
    state_ckv = jnp.stack(ckv_states, axis=1)
    state_krope = jnp.stack(kr_states, axis=1)

    rope = axial_rope(x_sample.shape[1])
    xs = x_sample
    for l in range(DEPTH):
        mod_lat = jax.nn.silu(c) @ w_mod[l] + b_mod[l]
        xs, _, _ = mixer_layer(xs, mod_lat, g_norm[l], w_in[l], g_q[l], w_uq[l], g_kv[l], w_ukv[l],
                               pool_w[l], pool_s[l], conv_w[l], w_out[l],
                               ctx=(cache_ckv[:, l], cache_krope[:, l]), rope=rope)
    y_sample = rmsnorm(xs, g_final)
    return (y_prompt, y_sample, state_ckv, state_krope)
```

```cpp
#include <hip/hip_runtime.h>
#include <hip/hip_cooperative_groups.h>
#include <stdint.h>
#include <stdio.h>
namespace cg = cooperative_groups;

#ifndef MK_MULTI
#define MK_MULTI 0
#endif

typedef unsigned short bf16_t;
typedef short bf16x8 __attribute__((ext_vector_type(8)));
typedef short bf16x4 __attribute__((ext_vector_type(4)));
typedef float f32x16 __attribute__((ext_vector_type(16)));
typedef float f32x4 __attribute__((ext_vector_type(4)));
typedef unsigned u32x4 __attribute__((ext_vector_type(4)));
typedef unsigned u32x2 __attribute__((ext_vector_type(2)));
#define LAS __attribute__((address_space(3)))

constexpr int D = 1024, INW = 2752, INWP = 2816, NTOK = 8192, NCTX = 4096;
constexpr int OFF_CKV = 384, OFF_KR = 640, OFF_GMLA = 704, OFF_PX = 1216, OFF_GPOOL = 1472, OFF_CB = 1728, OFF_CC = 1984, OFF_CH = 2240, OFF_GCONV = 2496;
constexpr int LKL = 1536, LKC = 256;
constexpr float EPS = 1e-6f;
constexpr float QSCALE = 0.07216878364870322f * 1.4426950408889634f;

enum { I_XP = 0, I_XS, I_CCKV, I_CKR, I_C, I_CCTX, I_WMOD, I_BMOD, I_GNORM, I_WIN, I_GQ, I_WUQ, I_GKV, I_WUKV, I_POOLW, I_POOLS, I_CONVW, I_WOUT, I_GFINAL, N_IN };

constexpr size_t WS_BAR = 0;
constexpr size_t WS_MOD = 16384;
constexpr size_t WS_COS = WS_MOD + 2 * 5 * 3072 * 4;
constexpr size_t WS_SIN = WS_COS + 1024 * 32 * 4;
constexpr size_t WS_WINT = WS_SIN + 1024 * 32 * 4;
constexpr size_t WS_WUQT = WS_WINT + (size_t)2 * INWP * 1024 * 2;
constexpr size_t WS_WUKVF = WS_WUQT + (size_t)2 * 768 * 384 * 2;
constexpr size_t WS_WUKVU = WS_WUKVF + (size_t)2 * 1024 * 256 * 2;
constexpr size_t WS_WOUTT = WS_WUKVU + (size_t)2 * 1024 * 256 * 2;
constexpr size_t WS_POOLWT = WS_WOUTT + (size_t)2 * 1024 * 1024 * 2;
constexpr size_t WS_CACHEA = WS_POOLWT + 2 * 4 * 64 * 64 * 2;
constexpr size_t WS_H = WS_CACHEA + (size_t)2 * 2048 * 256 * 2;
constexpr size_t WS_U = WS_H + (size_t)NTOK * 1024 * 2;
constexpr size_t WS_Q = WS_U + (size_t)NTOK * INW * 2;
constexpr size_t WS_KNL = WS_Q + (size_t)NTOK * 768 * 2;
constexpr size_t WS_VTL = WS_KNL + (size_t)2 * 16 * LKL * 128 * 2;
constexpr size_t WS_KRL = WS_VTL + (size_t)2 * 16 * LKL * 128 * 2;
constexpr size_t WS_KNC = WS_KRL + (size_t)2 * 4 * LKL * 64 * 2;
constexpr size_t WS_VTC = WS_KNC + (size_t)64 * LKC * 128 * 2;
constexpr size_t WS_KRC = WS_VTC + (size_t)64 * LKC * 128 * 2;
constexpr size_t WS_MIXED = WS_KRC + (size_t)16 * LKC * 64 * 2;
constexpr size_t WS_X1 = WS_MIXED + (size_t)NTOK * 1024 * 2;
constexpr size_t WS_SSP = WS_X1 + (size_t)NTOK * 1024 * 4;
constexpr size_t WS_SSF = WS_SSP + (size_t)NTOK * 16 * 4;
constexpr size_t WS_END = WS_SSF + (size_t)2 * 32 * 8 * 256 * 4;
constexpr int BC_CNT = 3456;
constexpr int MOD_CNT = 3457;
constexpr int XCHG_CNT = 3584;

constexpr int NT = 512;
constexpr int LDS_MAIN = 147456;
constexpr int LDS_BYTES = LDS_MAIN + 2048;
constexpr int LDS_RS = LDS_MAIN;
constexpr int LDS_XB = LDS_MAIN + 2032;
constexpr int LDS_PTR = LDS_MAIN + 1024;

struct Params {
    const float* in[N_IN];
    float* out;
    unsigned char* ws;
    int ph_lo, ph_hi, use_cg, pad;
};

__device__ __forceinline__ float bf2f(unsigned short h) { return __uint_as_float(((unsigned)h) << 16); }
__device__ __forceinline__ float bflo(unsigned w) { return __uint_as_float(w << 16); }
__device__ __forceinline__ float bfhi(unsigned w) { return __uint_as_float(w & 0xffff0000u); }
__device__ __forceinline__ unsigned pk2(float lo, float hi) { unsigned r; asm("v_cvt_pk_bf16_f32 %0, %1, %2" : "=v"(r) : "v"(lo), "v"(hi)); return r; }
__device__ __forceinline__ unsigned short f2bf(float f) { return (unsigned short)(pk2(f, 0.f) & 0xffffu); }
__device__ __forceinline__ float silu(float x) { return x / (1.f + __expf(-x)); }
__device__ __forceinline__ int rowmap(int i, int hf) { return (i & 3) + 8 * (i >> 2) + 4 * hf; }
__device__ __forceinline__ void unpack8(const u32x4& v, float (&f)[8]) {
    f[0] = bflo(v.x); f[1] = bfhi(v.x); f[2] = bflo(v.y); f[3] = bfhi(v.y); f[4] = bflo(v.z); f[5] = bfhi(v.z); f[6] = bflo(v.w); f[7] = bfhi(v.w);
}
__device__ __forceinline__ u32x4 pack8(const float (&f)[8]) { u32x4 r; r.x = pk2(f[0], f[1]); r.y = pk2(f[2], f[3]); r.z = pk2(f[4], f[5]); r.w = pk2(f[6], f[7]); return r; }


__device__ __forceinline__ unsigned char* lds_ptr(unsigned char* lds, int i) {
    volatile LAS unsigned* t = (volatile LAS unsigned*)(LAS unsigned char*)(lds + LDS_PTR);
    const unsigned lo = __builtin_amdgcn_readfirstlane(t[2 * i]), hi = __builtin_amdgcn_readfirstlane(t[2 * i + 1]);
    return (unsigned char*)(((unsigned long long)hi << 32) | (unsigned long long)lo);
}
#define IN(i) ((const float*)lds_ptr(lds, (i)))
#define OUTP() ((float*)lds_ptr(lds, N_IN))
#define WSP() (lds_ptr(lds, N_IN + 1))

#define XB_TMO      128
#define XB_XCNT(j)  (256  + 64 * (j))
#define XB_XSUB(j)  (1280 + 64 * (j))
#define XB_XGEN(j)  (2304 + 64 * (j))
#define XB_TOP      3328
#define XB_TOPGEN   3392
#define XCD_BAR_WORDS 3456
#define XB_SPIN_CAP (1u << 20)
__device__ __forceinline__ unsigned xb_ld(unsigned* p) { return __hip_atomic_load(p, __ATOMIC_RELAXED, __HIP_MEMORY_SCOPE_AGENT); }
__device__ __forceinline__ unsigned xb_add(unsigned* p, unsigned v) { return __hip_atomic_fetch_add(p, v, __ATOMIC_RELAXED, __HIP_MEMORY_SCOPE_AGENT); }
__device__ __forceinline__ unsigned xb_xcc_id() { return (unsigned)__builtin_amdgcn_s_getreg((3 << 11) | 20) & 0xFu; }
#define XB_SPIN(cond, bar) do { unsigned _sp = 0; while (cond) { __builtin_amdgcn_s_sleep(1); \
    if ((++_sp & 255u) == 0u) { if (xb_ld(&(bar)[XB_TMO])) break; if (_sp > XB_SPIN_CAP) { atomicAdd(&(bar)[XB_TMO], 1u); break; } } } } while (0)
struct XcdBarrier { unsigned* bar; unsigned x; volatile LAS unsigned* st; };
__device__ __forceinline__ XcdBarrier xcd_barrier_post(unsigned* bar, volatile LAS unsigned* st) {
    XcdBarrier b; b.bar = bar; b.x = xb_xcc_id(); b.st = st;
    if (threadIdx.x == 0) (void)xb_add(&bar[XB_XCNT(b.x)], 1u);
    return b;
}
__device__ __forceinline__ void xcd_barrier_complete(unsigned* bar, unsigned x, unsigned& nloc, unsigned& nx) {
    const unsigned G = gridDim.x * gridDim.y * gridDim.z;
    unsigned sum, cnt, mine, sp = 0u;
    for (;;) {
        sum = 0u; cnt = 0u; mine = 0u;
#pragma unroll
        for (unsigned j = 0; j < 16; ++j) { const unsigned c = xb_ld(&bar[XB_XCNT(j)]); sum += c; cnt += (c > 0u) ? 1u : 0u; mine = (j == x) ? c : mine; }
        if (sum == G) break;
        __builtin_amdgcn_s_sleep(1);
        if ((++sp & 255u) == 0u) { if (xb_ld(&bar[XB_TMO])) break; if (sp > XB_SPIN_CAP) { atomicAdd(&bar[XB_TMO], 1u); break; } }
    }
    nloc = mine > 0u ? mine : 1u; nx = cnt > 0u ? cnt : 1u;
}
__device__ __forceinline__ void xcd_barrier(const XcdBarrier& b) {
    asm volatile("s_waitcnt vmcnt(0)" ::: "memory");
    __syncthreads();
    if (threadIdx.x == 0) {
        unsigned* bar = b.bar;
        __builtin_amdgcn_s_waitcnt(0);
        unsigned nloc = b.st[0], nx = b.st[1];
        if (nloc == 0u) { xcd_barrier_complete(bar, b.x, nloc, nx); b.st[0] = nloc; b.st[1] = nx; }
        const unsigned old = xb_add(&bar[XB_XSUB(b.x)], 1u);
        const unsigned gen = old / nloc;
        if (old + 1u == (gen + 1u) * nloc) {
            __builtin_amdgcn_fence(__ATOMIC_RELEASE, "agent");
            asm volatile("s_waitcnt vmcnt(0)" ::: "memory");
            const unsigned og = xb_add(&bar[XB_TOP], 1u);
            const unsigned tg = og / nx;
            if (og + 1u == (tg + 1u) * nx) xb_add(&bar[XB_TOPGEN], 1u);
            else XB_SPIN(xb_ld(&bar[XB_TOPGEN]) == tg, bar);
            __builtin_amdgcn_fence(__ATOMIC_ACQUIRE, "agent");
            xb_add(&bar[XB_XGEN(b.x)], 1u);
            asm volatile("s_waitcnt vmcnt(0)" ::: "memory");
        } else {
            XB_SPIN(xb_ld(&bar[XB_XGEN(b.x)]) == gen, bar);
            __builtin_amdgcn_fence(__ATOMIC_ACQUIRE, "agent");
            asm volatile("s_waitcnt vmcnt(0)" ::: "memory");
        }
    }
    __syncthreads();
}

template <bool ROWSS>
__device__ __forceinline__ void gemm_mainloop(const bf16_t* __restrict__ A, int lda, const bf16_t* __restrict__ Bt, int ldb, int K, int m0, int n0,
                                              unsigned char* lds, f32x16 (&acc)[2][2], const int tid) {
    const int w = tid >> 6, lane = tid & 63, wr = w >> 1, wc = w & 1, hf = lane >> 5;
    const int srow = 8 * w + (lane >> 3);
    const int schunk = (lane & 7) ^ ((4 * w + (lane >> 4)) & 7);
    const bf16_t* pa = A + (size_t)(m0 + srow) * lda + schunk * 8;
    const bf16_t* pb = Bt + (size_t)(n0 + srow) * ldb + schunk * 8;
    const size_t a64 = (size_t)64 * lda, b64 = (size_t)64 * ldb;
    const int fswz = (lane >> 1) & 7;
    const int fa = (wr * 64 + (lane & 31)) * 128, fb = 32768 + (wc * 64 + (lane & 31)) * 128;
#pragma unroll
    for (int mt = 0; mt < 2; ++mt)
#pragma unroll
        for (int nt = 0; nt < 2; ++nt)
#pragma unroll
            for (int i = 0; i < 16; ++i) acc[mt][nt][i] = 0.f;
    const int nk = K >> 6;
#define GEMM_STAGE(boff, kt) do { \
        _Pragma("unroll") for (int i = 0; i < 4; ++i) \
            __builtin_amdgcn_global_load_lds((const unsigned*)(pa + i * a64 + (kt) * 64), (LAS unsigned*)(lds + (boff) + (8 * i + w) * 1024), 16, 0, 0); \
        _Pragma("unroll") for (int i = 0; i < 2; ++i) \
            __builtin_amdgcn_global_load_lds((const unsigned*)(pb + i * b64 + (kt) * 64), (LAS unsigned*)(lds + (boff) + 32768 + (8 * i + w) * 1024), 16, 0, 0); } while (0)
    GEMM_STAGE(0, 0); GEMM_STAGE(49152, 1);
    int cur = 0, nxt = 98304;
    for (int t = 0; t < nk; ++t) {
        if (t + 1 < nk) asm volatile("s_waitcnt vmcnt(6)" ::: "memory");
        else asm volatile("s_waitcnt vmcnt(0)" ::: "memory");
        __builtin_amdgcn_s_barrier();
        const unsigned char* base = lds + cur;
        bf16x8 fA0[2], fA1[2], fB0[2], fB1[2];
#define GEMM_LOADF(ks) do { const int sl = ((2 * (ks) + hf) ^ fswz) << 4; \
            fA0[(ks) & 1] = *(const bf16x8*)(base + fa + sl); fA1[(ks) & 1] = *(const bf16x8*)(base + fa + 32 * 128 + sl); \
            fB0[(ks) & 1] = *(const bf16x8*)(base + fb + sl); fB1[(ks) & 1] = *(const bf16x8*)(base + fb + 32 * 128 + sl); } while (0)
#define GEMM_MMA(ks) do { \
            acc[0][0] = __builtin_amdgcn_mfma_f32_32x32x16_bf16(fA0[(ks) & 1], fB0[(ks) & 1], acc[0][0], 0, 0, 0); \
            acc[0][1] = __builtin_amdgcn_mfma_f32_32x32x16_bf16(fA0[(ks) & 1], fB1[(ks) & 1], acc[0][1], 0, 0, 0); \
            acc[1][0] = __builtin_amdgcn_mfma_f32_32x32x16_bf16(fA1[(ks) & 1], fB0[(ks) & 1], acc[1][0], 0, 0, 0); \
            acc[1][1] = __builtin_amdgcn_mfma_f32_32x32x16_bf16(fA1[(ks) & 1], fB1[(ks) & 1], acc[1][1], 0, 0, 0); } while (0)
        GEMM_LOADF(0); GEMM_LOADF(1);
        __builtin_amdgcn_sched_barrier(0);
        if (t + 2 < nk) GEMM_STAGE(nxt, t + 2);
        __builtin_amdgcn_sched_barrier(0);
        GEMM_MMA(0); GEMM_LOADF(2);
        __builtin_amdgcn_sched_barrier(0);
        GEMM_MMA(1); GEMM_LOADF(3);
        __builtin_amdgcn_sched_barrier(0);
        GEMM_MMA(2);
        __builtin_amdgcn_sched_barrier(0);
        GEMM_MMA(3);
#undef GEMM_LOADF
#undef GEMM_MMA
        cur = (cur == 98304) ? 0 : cur + 49152;
        nxt = (nxt == 98304) ? 0 : nxt + 49152;
    }
#undef GEMM_STAGE
    __syncthreads();
}


__device__ __forceinline__ float half_reduce32(float (&v)[32], const int lane) {
#pragma unroll
    for (int k = 0; k < 5; ++k) {
        const bool b = (lane >> k) & 1;
        const int n = 16 >> k;
#pragma unroll
        for (int j = 0; j < n; ++j) {
            const float keep = b ? v[2 * j + 1] : v[2 * j];
            const float send = b ? v[2 * j] : v[2 * j + 1];
            v[j] = keep + __shfl_xor(send, 1 << k);
        }
    }
    return v[0];
}

__device__ __forceinline__ void epi_kv(const f32x16 (&acc)[2][2], int n0, bf16_t* kn, bf16_t* vt, int Lk, const float* rs, const int tid) {
    const int w = tid >> 6, lane = tid & 63, wr = w >> 1, wc = w & 1, hf = lane >> 5;
    const int nb = n0 + wc * 64;
    const int h = nb >> 8, within = nb & 255;
    if (within < 128) {
        bf16_t* base = kn + (size_t)h * Lk * 128;
#pragma unroll
        for (int mt = 0; mt < 2; ++mt)
#pragma unroll
            for (int i = 0; i < 16; ++i) {
                const int r = wr * 64 + mt * 32 + rowmap(i, hf);
                const float s = rs ? rs[r] : 1.f;
#pragma unroll
                for (int nt = 0; nt < 2; ++nt) base[(size_t)r * 128 + within + nt * 32 + (lane & 31)] = f2bf(acc[mt][nt][i] * s);
            }
    } else {
        bf16_t* base = vt + (size_t)h * 128 * Lk;
#pragma unroll
        for (int mt = 0; mt < 2; ++mt)
#pragma unroll
            for (int gq = 0; gq < 4; ++gq) {
                const int r = wr * 64 + mt * 32 + 8 * gq + 4 * hf;
                float s0 = 1.f, s1 = 1.f, s2 = 1.f, s3 = 1.f;
                if (rs) { s0 = rs[r]; s1 = rs[r + 1]; s2 = rs[r + 2]; s3 = rs[r + 3]; }
#pragma unroll
                for (int nt = 0; nt < 2; ++nt) {
                    const int d = within - 128 + nt * 32 + (lane & 31);
                    u32x2 v; v.x = pk2(acc[mt][nt][4 * gq] * s0, acc[mt][nt][4 * gq + 1] * s1); v.y = pk2(acc[mt][nt][4 * gq + 2] * s2, acc[mt][nt][4 * gq + 3] * s3);
                    *(u32x2*)(base + (size_t)d * Lk + (wr * 64 + mt * 32 + hf * 16 + gq * 4)) = v;
                }
            }
    }
}

__device__ __forceinline__ void transpose_tile(const float* __restrict__ src, int ldsrc, int k0, int n0, bf16_t* __restrict__ dst, int lddst, const float* __restrict__ gk, int nvalid, float* tile, const int tid, int nstore = 128) {
    {
        const int n = tid & 127, kq = tid >> 7;
        float v[16];
#pragma unroll
        for (int i = 0; i < 16; ++i) v[i] = (n < nvalid) ? __builtin_nontemporal_load(src + (size_t)(k0 + kq + 4 * i) * ldsrc + n0 + n) : 0.f;
#pragma unroll
        for (int i = 0; i < 16; ++i) {
            const int k = kq + 4 * i;
            tile[k * 129 + n] = gk ? v[i] * gk[k0 + k] : v[i];
        }
    }
    __syncthreads();
    const int nn = tid >> 2, kc = tid & 3;
    if (nn < nstore) {
#pragma unroll
        for (int j = 0; j < 2; ++j) {
            const int kb = (kc * 2 + j) * 8;
            float f[8];
#pragma unroll
            for (int q = 0; q < 8; ++q) f[q] = tile[(kb + q) * 129 + nn];
            *(u32x4*)(dst + (size_t)(n0 + nn) * lddst + k0 + kb) = pack8(f);
        }
    }
    __syncthreads();
}

__device__ __forceinline__ void phase_p0(const Params& p, unsigned char* lds) {
    constexpr int N_MOD = 192, N_WIN = 352, N_WUQ = 72, N_WUKV = 128, N_WOUT = 256, N_POOL = 8, N_ROPE = 64, N_CCKV = 256, N_CKR = 64;
    constexpr int E_MOD = N_MOD, E_WIN = E_MOD + N_WIN, E_WUQ = E_WIN + N_WUQ, E_WUKV = E_WUQ + N_WUKV, E_WOUT = E_WUKV + N_WOUT, E_POOL = E_WOUT + N_POOL,
                  E_ROPE = E_POOL + N_ROPE, E_CCKV = E_ROPE + N_CCKV, E_CKR = E_CCKV + N_CKR;
    float* tile = (float*)lds;
    for (int it = blockIdx.x; it < E_CKR; it += gridDim.x) {
        int tid = threadIdx.x; asm volatile("" : "+v"(tid));
        unsigned char* ws = WSP();
        if (it < E_MOD) {
            const int l = it / 96, cg0 = (it % 96) * 32;
            float* sc = (float*)lds;
            float* red = (float*)(lds + 20480);
            for (int e = tid; e < 5120; e += NT) {
                const int b = e >> 10, k = e & 1023;
                const float x = (b == 0) ? IN(I_CCTX)[k] : IN(I_C)[(b - 1) * 1024 + k];
                sc[e] = silu(x);
            }
            __syncthreads();
            const int kq = tid >> 3, c4 = tid & 7;
            const float* wm = IN(I_WMOD) + (size_t)l * 1024 * 3072 + cg0 + 4 * c4;
            f32x4 wv[16];
#pragma unroll
            for (int kk = 0; kk < 16; ++kk) wv[kk] = __builtin_nontemporal_load((const f32x4*)(wm + (size_t)(kq * 16 + kk) * 3072));
            f32x4 ab[5];
#pragma unroll
            for (int b = 0; b < 5; ++b) ab[b] = (f32x4){0.f, 0.f, 0.f, 0.f};
#pragma unroll
            for (int kk = 0; kk < 16; ++kk) {
                const int k = kq * 16 + kk;
#pragma unroll
                for (int b = 0; b < 5; ++b) { const float sv = sc[b * 1024 + k]; ab[b] += wv[kk] * sv; }
            }
#pragma unroll
            for (int b = 0; b < 5; ++b) *(f32x4*)(red + (kq * 5 + b) * 32 + 4 * c4) = ab[b];
            __syncthreads();
            if (tid < 160) {
                const int b = tid >> 5, c2 = tid & 31;
                float s = IN(I_BMOD)[l * 3072 + cg0 + c2];
#pragma unroll
                for (int q = 0; q < 64; ++q) s += red[(q * 5 + b) * 32 + c2];
                __hip_atomic_store(&((float*)(ws + WS_MOD))[(l * 5 + b) * 3072 + cg0 + c2], s, __ATOMIC_RELAXED, __HIP_MEMORY_SCOPE_AGENT);
            }
            asm volatile("s_waitcnt vmcnt(0)" ::: "memory");
            __syncthreads();
            if (tid == 0) (void)xb_add((unsigned*)(ws + WS_BAR) + MOD_CNT + 2 * l, 1u);
        } else if (it < E_WIN) {
            const int idx = it - E_MOD, l = idx / 352, rem = idx % 352, kt = rem / 22, nt = rem % 22;
            transpose_tile(IN(I_WIN) + (size_t)l * 1024 * INW, INW, kt * 64, nt * 128, (bf16_t*)(ws + WS_WINT) + (size_t)l * INWP * 1024, 1024, nullptr, INW - nt * 128, tile, tid);
        } else if (it < E_WUQ) {
            const int idx = it - E_WIN, l = idx / 36, rem = idx % 36, kt = rem / 6, nt = rem % 6;
            transpose_tile(IN(I_WUQ) + (size_t)l * 384 * 768, 768, kt * 64, nt * 128, (bf16_t*)(ws + WS_WUQT) + (size_t)l * 768 * 384, 384, IN(I_GQ) + l * 384, 128, tile, tid);
        } else if (it < E_WUKV) {
            const int idx = it - E_WUQ, l = idx / 64, rem = idx % 64, ver = rem / 32, r2 = rem % 32, kt = r2 / 8, nt = r2 % 8;
            transpose_tile(IN(I_WUKV) + (size_t)l * 256 * 1024, 1024, kt * 64, nt * 128, (bf16_t*)(ws + (ver ? WS_WUKVU : WS_WUKVF)) + (size_t)l * 1024 * 256, 256,
                           ver ? nullptr : IN(I_GKV) + l * 256, 128, tile, tid);
        } else if (it < E_WOUT) {
            const int idx = it - E_WUKV, l = idx / 128, rem = idx % 128, kt = rem / 8, nt = rem % 8;
            transpose_tile(IN(I_WOUT) + (size_t)l * 1024 * 1024, 1024, kt * 64, nt * 128, (bf16_t*)(ws + WS_WOUTT) + (size_t)l * 1024 * 1024, 1024, nullptr, 128, tile, tid);
        } else if (it < E_POOL) {
            const int idx = it - E_WOUT;
            transpose_tile(IN(I_POOLW) + (size_t)idx * 4096, 64, 0, 0, (bf16_t*)(ws + WS_POOLWT) + (size_t)idx * 4096, 64, nullptr, 64, tile, tid, 64);
        } else if (it < E_ROPE) {
            const int e = (it - E_POOL) * NT + tid, t = e >> 5, i = e & 31, f = i & 15;
            const float inv = exp2f(-(float)f * (13.287712379549449f / 16.0f));
            const float pos = (i < 16) ? (float)(t >> 6) : (float)(t & 63);
            const float ang = pos * inv;
            ((float*)(ws + WS_COS))[e] = cosf(ang);
            ((float*)(ws + WS_SIN))[e] = sinf(ang);
        } else if (it < E_CCKV) {
            const int e0 = (it - E_ROPE) * 4096 + tid * 8;
            const int c = e0 & 255, t = (e0 >> 8) & 511, l = (e0 >> 17) & 1, b = e0 >> 18;
            const f32x4 v0 = __builtin_nontemporal_load((const f32x4*)(IN(I_CCKV) + e0)), v1 = __builtin_nontemporal_load((const f32x4*)(IN(I_CCKV) + e0 + 4));
            u32x4 o; o.x = pk2(v0[0], v0[1]); o.y = pk2(v0[2], v0[3]); o.z = pk2(v1[0], v1[1]); o.w = pk2(v1[2], v1[3]);
            *(u32x4*)((bf16_t*)(ws + WS_CACHEA) + ((size_t)(l * 2048 + b * 512 + t)) * 256 + c) = o;
        } else {
            const int e0 = (it - E_CCKV) * 4096 + tid * 8;
            const int c = e0 & 63, t = (e0 >> 6) & 511, l = (e0 >> 15) & 1, b = e0 >> 16;
            const f32x4 v0 = __builtin_nontemporal_load((const f32x4*)(IN(I_CKR) + e0)), v1 = __builtin_nontemporal_load((const f32x4*)(IN(I_CKR) + e0 + 4));
            u32x4 o; o.x = pk2(v0[0], v0[1]); o.y = pk2(v0[2], v0[3]); o.z = pk2(v1[0], v1[1]); o.w = pk2(v1[2], v1[3]);
            *(u32x4*)((bf16_t*)(ws + WS_KRL) + ((size_t)((l * 4 + b) * LKL + t)) * 64 + c) = o;
        }
    }
}

__device__ __forceinline__ void phase_a(const Params& p, int l, unsigned char* lds) {
    const int n_gemm = 0;
    const int total = n_gemm + 256;
    if (l == 0) {
        int tid0 = threadIdx.x; asm volatile("" : "+v"(tid0));
        if (tid0 == 0) {
            unsigned* c = (unsigned*)(WSP() + WS_BAR) + MOD_CNT;
            unsigned sp = 0u;
            while (xb_ld(c) < 96u) { __builtin_amdgcn_s_sleep(1); if (++sp > (1u << 22)) break; }
            __builtin_amdgcn_fence(__ATOMIC_ACQUIRE, "agent");
            asm volatile("s_waitcnt vmcnt(0)" ::: "memory");
        }
        __syncthreads();
    }
    for (int it = blockIdx.x; it < total; it += gridDim.x) {
        int tid = threadIdx.x; asm volatile("" : "+v"(tid));
        unsigned char* ws = WSP();
        const int w = tid >> 6, lane = tid & 63;
        if (it < n_gemm) {
            const int ll = it >> 6, rem = it & 63, mt = rem >> 3, nt = rem & 7;
            f32x16 acc[2][2];
            const int m0 = mt * 256, n0 = nt * 128;
            gemm_mainloop<false>((const bf16_t*)(ws + WS_CACHEA) + (size_t)ll * 2048 * 256, 256, (const bf16_t*)(ws + WS_WUKVU) + (size_t)ll * 1024 * 256, 256, 256, m0, n0, lds, acc, tid);
            const int b = m0 >> 9, key0 = m0 & 511;
            bf16_t* kn = (bf16_t*)(ws + WS_KNL) + ((size_t)(ll * 16 + b * 4) * LKL + key0) * 128;
            bf16_t* vt = (bf16_t*)(ws + WS_VTL) + (size_t)(ll * 16 + b * 4) * 128 * LKL + key0;
            epi_kv(acc, n0, kn, vt, LKL, nullptr, tid);
        } else {
            f32x4 v[4][4];
#pragma unroll
            for (int r = 0; r < 4; ++r) {
                const int row = (it - n_gemm) * 32 + w * 4 + r;
                const float* x = (l == 0) ? (row < NCTX ? IN(I_XP) + (size_t)row * D : IN(I_XS) + (size_t)(row - NCTX) * D) : (const float*)(ws + WS_X1) + (size_t)row * D;
#pragma unroll
                for (int j = 0; j < 4; ++j) v[r][j] = *(const f32x4*)(x + (lane + 64 * j) * 4);
            }
            const float* g = IN(I_GNORM) + l * D;
#pragma unroll
            for (int r = 0; r < 4; ++r) {
                const int row = (it - n_gemm) * 32 + w * 4 + r;
                const int bidx = row < NCTX ? 0 : 1 + ((row - NCTX) >> 10);
                const float* mod = (const float*)(ws + WS_MOD) + (size_t)(l * 5 + bidx) * 3072;
                float ss = 0.f;
#pragma unroll
                for (int j = 0; j < 4; ++j) ss += v[r][j][0] * v[r][j][0] + v[r][j][1] * v[r][j][1] + v[r][j][2] * v[r][j][2] + v[r][j][3] * v[r][j][3];
#pragma unroll
                for (int o = 32; o >= 1; o >>= 1) ss += __shfl_xor(ss, o);
                const float rstd = rsqrtf(ss * (1.f / 1024.f) + EPS);
                bf16_t* hrow = (bf16_t*)(ws + WS_H) + (size_t)row * D;
#pragma unroll
                for (int j = 0; j < 4; ++j) {
                    const int k = (lane + 64 * j) * 4;
                    const f32x4 gg = *(const f32x4*)(g + k), sh = *(const f32x4*)(mod + k), sc = *(const f32x4*)(mod + 1024 + k);
                    float o0 = v[r][j][0] * rstd * gg[0] * (1.f + sc[0]) + sh[0], o1 = v[r][j][1] * rstd * gg[1] * (1.f + sc[1]) + sh[1];
                    float o2 = v[r][j][2] * rstd * gg[2] * (1.f + sc[2]) + sh[2], o3 = v[r][j][3] * rstd * gg[3] * (1.f + sc[3]) + sh[3];
                    u32x2 o; o.x = pk2(o0, o1); o.y = pk2(o2, o3);
                    *(u32x2*)(hrow + k) = o;
                }
            }
        }
    }
}

__device__ __forceinline__ void phase_b(const Params& p, int l, unsigned char* lds) {
    for (int it = blockIdx.x; it < 32 * 22 + 64; it += gridDim.x) {
        int tid = threadIdx.x; asm volatile("" : "+v"(tid));
        unsigned char* ws = WSP();
        bf16_t* U = (bf16_t*)(ws + WS_U);
        const int w = tid >> 6, lane = tid & 63, wr = w >> 1, wc = w & 1, hf = lane >> 5;
        if (it >= 704) {
            const int r = it - 704, m0 = (r >> 3) * 256, n0 = (r & 7) * 128;
            f32x16 acc[2][2];
            gemm_mainloop<false>((const bf16_t*)(ws + WS_CACHEA) + (size_t)l * 2048 * 256, 256, (const bf16_t*)(ws + WS_WUKVU) + (size_t)l * 1024 * 256, 256, 256, m0, n0, lds, acc, tid);
            const int b = m0 >> 9, key0 = m0 & 511;
            bf16_t* kn = (bf16_t*)(ws + WS_KNL) + ((size_t)(l * 16 + b * 4) * LKL + key0) * 128;
            bf16_t* vt = (bf16_t*)(ws + WS_VTL) + (size_t)(l * 16 + b * 4) * 128 * LKL + key0;
            epi_kv(acc, n0, kn, vt, LKL, nullptr, tid);
            continue;
        }
        int mt_, nt_;
        if (it < 192) { const int xi_ = it >> 3; mt_ = (it & 7) * 4 + xi_ / 6; nt_ = xi_ % 6; }
        else { const int j_ = it - 192, xi_ = j_ >> 3; mt_ = (j_ & 7) * 4 + (xi_ >> 4); nt_ = 6 + (xi_ & 15); }
        const int m0 = mt_ * 256, n0 = nt_ * 128;
        f32x16 acc[2][2];
        gemm_mainloop<false>((const bf16_t*)(ws + WS_H), 1024, (const bf16_t*)(ws + WS_WINT) + (size_t)l * INWP * 1024, 1024, 1024, m0, n0, lds, acc, tid);
#pragma unroll
        for (int nt = 0; nt < 2; ++nt) {
            const int n = n0 + wc * 64 + nt * 32 + (lane & 31);
            if (n < INW) {
#pragma unroll
                for (int mt = 0; mt < 2; ++mt)
#pragma unroll
                    for (int i = 0; i < 16; ++i) {
                        const int m = m0 + wr * 64 + mt * 32 + rowmap(i, hf);
                        U[(size_t)m * INW + n] = f2bf(acc[mt][nt][i]);
                    }
            }
        }
        if (nt_ < 5) {
            float v[32];
#pragma unroll
            for (int mt = 0; mt < 2; ++mt)
#pragma unroll
                for (int i = 0; i < 16; ++i) v[mt * 16 + i] = acc[mt][0][i] * acc[mt][0][i] + acc[mt][1][i] * acc[mt][1][i];
            const float tot = half_reduce32(v, lane);
            const int j = lane & 31;
            const int m = m0 + wr * 64 + (j >> 4) * 32 + rowmap(j & 15, hf);
            ((float*)(ws + WS_SSP))[(size_t)m * 16 + nt_ * 2 + wc] = tot;
        }
        if (nt_ < 6) {
            asm volatile("s_waitcnt vmcnt(0)" ::: "memory");
            __syncthreads();
            if (tid == 0) {
                __builtin_amdgcn_fence(__ATOMIC_RELEASE, "agent");
                asm volatile("s_waitcnt vmcnt(0)" ::: "memory");
                (void)xb_add((unsigned*)(ws + WS_BAR) + BC_CNT + (l * 32 + mt_) * 2, 1u);
            }
        }
    }
}

__device__ __forceinline__ void mixer_pool_conv(int item, int l, unsigned char* lds) {
        int tid = threadIdx.x; asm volatile("" : "+v"(tid));
        unsigned char* ws = WSP();
        const bf16_t* U = (const bf16_t*)(ws + WS_U);
        bf16_t* MIX = (bf16_t*)(ws + WS_MIXED);
        const int w = tid >> 6, lane = tid & 63, hf = lane >> 5;
        {
            const int R0 = item * 64;
            const bool ctx = R0 < NCTX;
            const int t0 = ctx ? (R0 & 255) : ((R0 - NCTX) & 1023);
            const int L = ctx ? 256 : 1024;
            const int rowbase = R0 - t0;
            {
                __syncthreads();
#pragma unroll
                for (int i = 0; i < 5; ++i) {
                    const int id = tid + NT * i, r = id >> 5, ck = id & 31, s = t0 - 8 + r;
                    u32x4 v = {0u, 0u, 0u, 0u};
                    if (s >= 0 && s < L) v = *(const u32x4*)(U + (size_t)(rowbase + s) * INW + OFF_PX + ck * 8);
                    *(u32x4*)(lds + r * 528 + ck * 16) = v;
                }
                __syncthreads();
                const int g = w & 3, th = w >> 2, half = 1 << g;
                const int tok = th * 32 + (lane & 31), t = t0 + tok;
                const int lo = max(t - half, 0), hi = min(t + half, L);
                const float rc = 1.f / (float)(hi - lo);
                bf16x8 af[4];
                {
                    float sum[4][8];
#pragma unroll
                    for (int ks = 0; ks < 4; ++ks)
#pragma unroll
                        for (int q = 0; q < 8; ++q) sum[ks][q] = 0.f;
                    const unsigned char* pb = lds + (tok + 8) * 528 + g * 128 + hf * 16;
#pragma unroll 2
                    for (int d = -half; d < half; ++d) {
#pragma unroll
                        for (int ks = 0; ks < 4; ++ks) {
                            const u32x4 v = *(const u32x4*)(pb + d * 528 + ks * 32);
                            float f[8]; unpack8(v, f);
#pragma unroll
                            for (int q = 0; q < 8; ++q) sum[ks][q] += f[q];
                        }
                    }
#pragma unroll
                    for (int ks = 0; ks < 4; ++ks) {
                        const u32x4 sv = *(const u32x4*)(pb + ks * 32);
                        float f[8]; unpack8(sv, f);
#pragma unroll
                        for (int q = 0; q < 8; ++q) sum[ks][q] = sum[ks][q] * rc - f[q];
                        const u32x4 pk = pack8(sum[ks]);
                        af[ks] = *(const bf16x8*)&pk;
                    }
                }
                const bf16_t* pw = (const bf16_t*)(ws + WS_POOLWT) + (size_t)(l * 4 + g) * 4096;
                f32x16 pacc[2];
#pragma unroll
                for (int nt = 0; nt < 2; ++nt) {
#pragma unroll
                    for (int i = 0; i < 16; ++i) pacc[nt][i] = 0.f;
#pragma unroll
                    for (int ks = 0; ks < 4; ++ks) {
                        const bf16x8 bfr = *(const bf16x8*)(pw + (nt * 32 + (lane & 31)) * 64 + 16 * ks + 8 * hf);
                        pacc[nt] = __builtin_amdgcn_mfma_f32_32x32x16_bf16(af[ks], bfr, pacc[nt], 0, 0, 0);
                    }
                }
#pragma unroll
                for (int nt = 0; nt < 2; ++nt) {
                    const int ch = g * 64 + nt * 32 + (lane & 31);
                    const float ps = IN(I_POOLS)[l * 256 + ch];
#pragma unroll
                    for (int i = 0; i < 16; ++i) {
                        const int row = R0 + th * 32 + rowmap(i, hf);
                        const float gp = bf2f(U[(size_t)row * INW + OFF_GPOOL + ch]);
                        MIX[(size_t)row * D + 512 + ch] = f2bf(pacc[nt][i] * ps * silu(gp));
                    }
                }
            }
            {
                const float* cw = IN(I_CONVW) + l * 768;
#pragma unroll 2
                for (int i = 0; i < 4; ++i) {
                    const int id = tid + NT * i, tt = id >> 5, c0 = (id & 31) * 8, t = t0 + tt;
                    const bf16_t* ur = U + (size_t)(rowbase + t) * INW;
                    const u32x4 zero4 = {0u, 0u, 0u, 0u};
                    const u32x4 ccm = (t > 0) ? *(const u32x4*)(ur - INW + OFF_CC + c0) : zero4, chm = (t > 0) ? *(const u32x4*)(ur - INW + OFF_CH + c0) : zero4;
                    const u32x4 cc0 = *(const u32x4*)(ur + OFF_CC + c0), ch0 = *(const u32x4*)(ur + OFF_CH + c0);
                    const u32x4 ccp = (t + 1 < L) ? *(const u32x4*)(ur + INW + OFF_CC + c0) : zero4, chp = (t + 1 < L) ? *(const u32x4*)(ur + INW + OFF_CH + c0) : zero4;
                    const u32x4 cbv = *(const u32x4*)(ur + OFF_CB + c0), gcv = *(const u32x4*)(ur + OFF_GCONV + c0);
                    float a[8], b2[8], zm[8], z0[8], zp[8], cb[8], gc[8], o[8];
                    unpack8(ccm, a); unpack8(chm, b2);
#pragma unroll
                    for (int q = 0; q < 8; ++q) zm[q] = a[q] * b2[q];
                    unpack8(cc0, a); unpack8(ch0, b2);
#pragma unroll
                    for (int q = 0; q < 8; ++q) z0[q] = a[q] * b2[q];
                    unpack8(ccp, a); unpack8(chp, b2);
#pragma unroll
                    for (int q = 0; q < 8; ++q) zp[q] = a[q] * b2[q];
                    unpack8(cbv, cb); unpack8(gcv, gc);
#pragma unroll
                    for (int q = 0; q < 8; ++q) {
                        const float cv = zm[q] * cw[c0 + q] + z0[q] * cw[256 + c0 + q] + zp[q] * cw[512 + c0 + q];
                        o[q] = cb[q] * cv * silu(gc[q]);
                    }
                    *(u32x4*)(MIX + (size_t)(rowbase + t) * D + 768 + c0) = pack8(o);
                }
            }
        }
        __syncthreads();
}

__device__ __forceinline__ void bc_wait_all(unsigned char* lds, int l) {
    int tid = threadIdx.x; asm volatile("" : "+v"(tid));
    unsigned char* ws = WSP();
    if (tid < 64) {
        if (tid < 32) {
            unsigned* c = (unsigned*)(ws + WS_BAR) + BC_CNT + (l * 32 + tid) * 2;
            unsigned sp = 0u;
            while (xb_ld(c) < 6u) { __builtin_amdgcn_s_sleep(1); if (++sp > (1u << 22)) break; }
        }
        __builtin_amdgcn_fence(__ATOMIC_ACQUIRE, "agent");
        asm volatile("s_waitcnt vmcnt(0)" ::: "memory");
    }
    __syncthreads();
}

__device__ __forceinline__ void phase_c(const Params& p, int l, unsigned char* lds) {
    constexpr int N_C3 = 128, N_C2 = 256, N_C1 = 192;
    bc_wait_all(lds, l);
    const bool bal = (gridDim.x == 256);
    const int bid_ = blockIdx.x;
    int li0, li1, li2, nli;
    if (bid_ >= 192) { const int k = bid_ - 192; li0 = N_C3 + k; li1 = N_C3 + 64 + k; li2 = N_C3 + N_C2 + k; nli = 3; }
    else if (bid_ >= 128) { const int j = bid_ - 128; li0 = N_C3 + 128 + j; li1 = N_C3 + 192 + j; li2 = 0; nli = 2; }
    else { li0 = N_C3 + N_C2 + 64 + bid_; li1 = bid_; li2 = 0; nli = 2; }
    for (int q_ = 0; ; ++q_) {
        int it;
        if (bal) { if (q_ >= nli) break; it = (q_ == 0) ? li0 : ((q_ == 1) ? li1 : li2); }
        else { const int it_ = bid_ + q_ * (int)gridDim.x; if (it_ >= N_C3 + N_C2 + N_C1) break; it = it_ < N_C2 + N_C1 ? it_ + N_C3 : it_ - (N_C2 + N_C1); }
        int tid = threadIdx.x; asm volatile("" : "+v"(tid));
        unsigned char* ws = WSP();
        const bf16_t* U = (const bf16_t*)(ws + WS_U);
        bf16_t* MIX = (bf16_t*)(ws + WS_MIXED);
        const float* costab = (const float*)(ws + WS_COS);
        const float* sintab = (const float*)(ws + WS_SIN);
        const int w = tid >> 6, lane = tid & 63, wr = w >> 1, wc = w & 1, hf = lane >> 5;
#ifndef C_MASK
#define C_MASK 7
#endif
        if (it < N_C3) { if (C_MASK & 1) {
            const int R0 = it * 64;
            const bool ctx = R0 < NCTX;
            const int b = ctx ? (R0 >> 8) : ((R0 - NCTX) >> 10);
            const int t0 = ctx ? (R0 & 255) : ((R0 - NCTX) & 1023);
            const int L = ctx ? 256 : 1024;
            const int rowbase = R0 - t0;
            {
                const int tok = tid >> 3, sub = tid & 7, row = R0 + tok, t = t0 + tok;
                const bf16_t* ur = U + (size_t)row * INW;
                u32x4 cv[4]; float ss = 0.f;
#pragma unroll
                for (int j = 0; j < 4; ++j) {
                    cv[j] = *(const u32x4*)(ur + OFF_CKV + sub * 32 + j * 8);
                    float f[8]; unpack8(cv[j], f);
#pragma unroll
                    for (int q = 0; q < 8; ++q) ss += f[q] * f[q];
                }
                ss += __shfl_xor(ss, 1); ss += __shfl_xor(ss, 2); ss += __shfl_xor(ss, 4);
                const float rstd = rsqrtf(ss * (1.f / 256.f) + EPS);
                const u32x4 kv = *(const u32x4*)(ur + OFF_KR + sub * 8);
                float kf[8]; unpack8(kv, kf);
                if (ctx) {
                    float* oc = OUTP() + (size_t)2 * NCTX * D + ((size_t)((b * 2 + l) * 256 + t)) * 256 + sub * 32;
                    const float* gk = IN(I_GKV) + l * 256 + sub * 32;
#pragma unroll
                    for (int j = 0; j < 4; ++j) {
                        float f[8]; unpack8(cv[j], f);
                        f32x4 o0, o1;
#pragma unroll
                        for (int q = 0; q < 4; ++q) { o0[q] = f[q] * rstd * gk[j * 8 + q]; o1[q] = f[4 + q] * rstd * gk[j * 8 + 4 + q]; }
                        __builtin_nontemporal_store(o0, (f32x4*)(oc + j * 8)); __builtin_nontemporal_store(o1, (f32x4*)(oc + j * 8 + 4));
                    }
                    float* ok = OUTP() + (size_t)2 * NCTX * D + (size_t)16 * 2 * 256 * 256 + ((size_t)((b * 2 + l) * 256 + t)) * 64 + sub * 8;
                    f32x4 k0, k1;
#pragma unroll
                    for (int q = 0; q < 4; ++q) { k0[q] = kf[q]; k1[q] = kf[4 + q]; }
                    __builtin_nontemporal_store(k0, (f32x4*)ok); __builtin_nontemporal_store(k1, (f32x4*)(ok + 4));
                    *(u32x4*)((bf16_t*)(ws + WS_KRC) + ((size_t)(b * LKC + t)) * 64 + sub * 8) = kv;
                } else {
                    float o[8];
                    const int ib = (sub & 3) * 8;
#pragma unroll
                    for (int q = 0; q < 8; ++q) {
                        const float other = __shfl_xor(kf[q], 4);
                        const float cs = costab[t * 32 + ib + q], sn = sintab[t * 32 + ib + q];
                        o[q] = (sub < 4) ? (kf[q] * cs - other * sn) : (kf[q] * cs + other * sn);
                    }
                    *(u32x4*)((bf16_t*)(ws + WS_KRL) + ((size_t)((l * 4 + b) * LKL + 512 + t)) * 64 + sub * 8) = pack8(o);
                }
            }
        } } else if (it < N_C3 + N_C2) { if (C_MASK & 2) {
            const int idx = it - N_C3, xi_ = idx >> 3, mt_ = (idx & 7) * 4 + (xi_ >> 3), nt_ = xi_ & 7, m0 = mt_ * 256, n0 = nt_ * 128;
            f32x16 acc[2][2];
            __syncthreads();
            if (tid < 256) {
                const float* sp = (const float*)(ws + WS_SSP) + (size_t)(m0 + tid) * 16;
                ((float*)(lds + LDS_RS))[tid] = rsqrtf(((sp[6] + sp[7]) + (sp[8] + sp[9])) * (1.f / 256.f) + EPS);
            }
            gemm_mainloop<false>(U + OFF_CKV, INW, (const bf16_t*)(ws + WS_WUKVF) + (size_t)l * 1024 * 256, 256, 256, m0, n0, lds, acc, tid);
            bf16_t *kn, *vt; int Lk;
            if (m0 < NCTX) {
                const int b = m0 >> 8, key0 = m0 & 255; Lk = LKC;
                kn = (bf16_t*)(ws + WS_KNC) + ((size_t)(b * 4) * LKC + key0) * 128;
                vt = (bf16_t*)(ws + WS_VTC) + (size_t)(b * 4) * 128 * LKC + key0;
            } else {
                const int b = (m0 - NCTX) >> 10, key0 = 512 + ((m0 - NCTX) & 1023); Lk = LKL;
                kn = (bf16_t*)(ws + WS_KNL) + ((size_t)(l * 16 + b * 4) * LKL + key0) * 128;
                vt = (bf16_t*)(ws + WS_VTL) + (size_t)(l * 16 + b * 4) * 128 * LKL + key0;
            }
            epi_kv(acc, n0, kn, vt, Lk, (const float*)(lds + LDS_RS), tid);
        } } else { if (C_MASK & 4) {
            const int idx = it - N_C3 - N_C2, xi_ = idx >> 3, mt_ = (idx & 7) * 4 + xi_ / 6, nt_ = xi_ % 6, m0 = mt_ * 256, n0 = nt_ * 128;
            f32x16 acc[2][2];
            __syncthreads();
            if (tid < 256) {
                const float* sp = (const float*)(ws + WS_SSP) + (size_t)(m0 + tid) * 16;
                ((float*)(lds + LDS_RS))[tid] = rsqrtf((((sp[0] + sp[1]) + (sp[2] + sp[3])) + (sp[4] + sp[5])) * (1.f / 384.f) + EPS);
            }
            gemm_mainloop<false>(U, INW, (const bf16_t*)(ws + WS_WUQT) + (size_t)l * 768 * 384, 384, 384, m0, n0, lds, acc, tid);
            const float* rs = (const float*)(lds + LDS_RS);
            bf16_t* Q = (bf16_t*)(ws + WS_Q);
            const int nb = n0 + wc * 64;
            const bool rope = ((nb >> 6) % 3 == 2) && (m0 >= NCTX);
#pragma unroll
            for (int mt = 0; mt < 2; ++mt)
#pragma unroll
                for (int i = 0; i < 16; ++i) {
                    const int r = wr * 64 + mt * 32 + rowmap(i, hf), m = m0 + r;
                    const float s = rs[r] * QSCALE;
                    float v0 = acc[mt][0][i] * s, v1 = acc[mt][1][i] * s;
                    if (rope) {
                        const int t = (m - NCTX) & 1023;
                        const float cs = costab[t * 32 + (lane & 31)], sn = sintab[t * 32 + (lane & 31)];
                        const float o0 = v0 * cs - v1 * sn, o1 = v1 * cs + v0 * sn;
                        v0 = o0; v1 = o1;
                    }
                    Q[(size_t)m * 768 + nb + (lane & 31)] = f2bf(v0);
                    Q[(size_t)m * 768 + nb + 32 + (lane & 31)] = f2bf(v1);
                }
        } }
    }
}

constexpr int ATT_STAGE = 40960, ATT_VOFF = 24576;
__device__ __forceinline__ void phase_d(const Params& p, int l, unsigned char* lds) {
    for (int it = blockIdx.x; it < 256; it += gridDim.x) {
        int tid = threadIdx.x; asm volatile("" : "+v"(tid));
        unsigned char* ws = WSP();
        const bf16_t* U = (const bf16_t*)(ws + WS_U);
        const bf16_t* Q = (const bf16_t*)(ws + WS_Q);
        bf16_t* MIX = (bf16_t*)(ws + WS_MIXED);
        const int w = tid >> 6, lane = tid & 63, hf = lane >> 5;
        const int qh = w & 3, kh = w >> 2;
        const int fswz = (lane >> 1) & 7;
        int h, Lk, rowq0; const bf16_t *Kn, *Vt, *Kr;
        if (it < 128) {
            const int xs_ = it >> 3, bh_ = (it & 7) * 2 + (xs_ >> 3), b = bh_ >> 2, qb = xs_ & 7; h = bh_ & 3;   Lk = LKL; rowq0 = NCTX + b * 1024 + qb * 128;
            Kn = (const bf16_t*)(ws + WS_KNL) + (size_t)(l * 16 + b * 4 + h) * LKL * 128;
            Vt = (const bf16_t*)(ws + WS_VTL) + (size_t)(l * 16 + b * 4 + h) * 128 * LKL;
            Kr = (const bf16_t*)(ws + WS_KRL) + (size_t)(l * 4 + b) * LKL * 64;
        } else {
            const int j = it - 128, xs_ = j >> 3, bh_ = (j & 7) * 8 + (xs_ >> 1), b = bh_ >> 2, qb = xs_ & 1; h = bh_ & 3; Lk = LKC; rowq0 = b * 256 + qb * 128;
            Kn = (const bf16_t*)(ws + WS_KNC) + (size_t)(b * 4 + h) * LKC * 128;
            Vt = (const bf16_t*)(ws + WS_VTC) + (size_t)(b * 4 + h) * 128 * LKC;
            Kr = (const bf16_t*)(ws + WS_KRC) + (size_t)b * LKC * 64;
        }
        const int qrow = rowq0 + qh * 32 + (lane & 31);
        bf16x8 qf[12];
#pragma unroll
        for (int ks = 0; ks < 12; ++ks) qf[ks] = *(const bf16x8*)(Q + (size_t)qrow * 768 + h * 192 + 16 * ks + 8 * hf);
        f32x16 O[4];
#pragma unroll
        for (int dt = 0; dt < 4; ++dt)
#pragma unroll
            for (int i = 0; i < 16; ++i) O[dt][i] = 0.f;
        float mrun = -1e30f, lrun = 0.f;
        const int srow = 8 * w + (lane >> 3);
        const int schunk = (lane & 7) ^ ((4 * w + (lane >> 4)) & 7);
        const bf16_t* pkn = Kn + (size_t)srow * 128 + schunk * 8;
        const bf16_t* pkr = Kr + (size_t)srow * 64 + schunk * 8;
        const bf16_t* pv = Vt + (size_t)srow * Lk + schunk * 8;
        const size_t v64 = (size_t)64 * Lk;
        const int nsteps = Lk >> 6;
#define ATT_STAGE_LOAD(boff, st) do { const int key0 = (st) * 64; \
        __builtin_amdgcn_global_load_lds((const unsigned*)(pkn + (size_t)key0 * 128), (LAS unsigned*)(lds + (boff) + w * 1024), 16, 0, 0); \
        __builtin_amdgcn_global_load_lds((const unsigned*)(pkn + (size_t)key0 * 128 + 64), (LAS unsigned*)(lds + (boff) + (8 + w) * 1024), 16, 0, 0); \
        __builtin_amdgcn_global_load_lds((const unsigned*)(pkr + (size_t)key0 * 64), (LAS unsigned*)(lds + (boff) + (16 + w) * 1024), 16, 0, 0); \
        __builtin_amdgcn_global_load_lds((const unsigned*)(pv + key0), (LAS unsigned*)(lds + (boff) + ATT_VOFF + w * 1024), 16, 0, 0); \
        __builtin_amdgcn_global_load_lds((const unsigned*)(pv + v64 + key0), (LAS unsigned*)(lds + (boff) + ATT_VOFF + (8 + w) * 1024), 16, 0, 0); } while (0)
        ATT_STAGE_LOAD(0, 0); ATT_STAGE_LOAD(ATT_STAGE, 1);
        int cur = 0, nxt = 2 * ATT_STAGE;
        for (int st = 0; st < nsteps; ++st) {
            if (st + 1 < nsteps) asm volatile("s_waitcnt vmcnt(5)" ::: "memory");
            else asm volatile("s_waitcnt vmcnt(0)" ::: "memory");
            __builtin_amdgcn_s_barrier();
            const unsigned char* kbase = lds + cur;
            {
                const int sub = kh;
                f32x16 S;
#pragma unroll
                for (int i = 0; i < 16; ++i) S[i] = 0.f;
                const unsigned char* kb = kbase + (sub * 32 + (lane & 31)) * 128;
                {
                    const bf16x8 kf0 = *(const bf16x8*)(kb + (((0 + hf) ^ fswz) << 4));
                    const bf16x8 kf1 = *(const bf16x8*)(kb + (((2 + hf) ^ fswz) << 4));
                    __builtin_amdgcn_sched_barrier(0);
                    if (st + 2 < nsteps) ATT_STAGE_LOAD(nxt, st + 2);
                    __builtin_amdgcn_sched_barrier(0);
                    S = __builtin_amdgcn_mfma_f32_32x32x16_bf16(kf0, qf[0], S, 0, 0, 0);
                    S = __builtin_amdgcn_mfma_f32_32x32x16_bf16(kf1, qf[1], S, 0, 0, 0);
                }
#pragma unroll
                for (int ks = 2; ks < 12; ++ks) {
                    const bf16x8 kf = *(const bf16x8*)(kb + (ks >> 2) * 8192 + (((2 * (ks & 3) + hf) ^ fswz) << 4));
                    S = __builtin_amdgcn_mfma_f32_32x32x16_bf16(kf, qf[ks], S, 0, 0, 0);
                }
                float tmax = S[0];
#pragma unroll
                for (int i = 1; i < 16; ++i) tmax = fmaxf(tmax, S[i]);
                tmax = fmaxf(tmax, __shfl_xor(tmax, 32));
                if (__builtin_amdgcn_ballot_w64(tmax > mrun + 8.f) != 0ull) {
                    const float mnew = fmaxf(mrun, tmax);
                    const float alpha = __builtin_amdgcn_exp2f(mrun - mnew);
                    mrun = mnew;
                    lrun *= alpha;
#pragma unroll
                    for (int dt = 0; dt < 4; ++dt)
#pragma unroll
                        for (int i = 0; i < 16; ++i) O[dt][i] *= alpha;
                }
                float psum = 0.f;
#pragma unroll
                for (int i = 0; i < 16; ++i) { S[i] = __builtin_amdgcn_exp2f(S[i] - mrun); psum += S[i]; }
                lrun += psum;
                bf16x8 pf[2];
#pragma unroll
                for (int s2 = 0; s2 < 2; ++s2) {
                    u32x4 pk; pk.x = pk2(S[8 * s2], S[8 * s2 + 1]); pk.y = pk2(S[8 * s2 + 2], S[8 * s2 + 3]); pk.z = pk2(S[8 * s2 + 4], S[8 * s2 + 5]); pk.w = pk2(S[8 * s2 + 6], S[8 * s2 + 7]);
                    pf[s2] = *(const bf16x8*)&pk;
                }
#pragma unroll
                for (int dt = 0; dt < 4; ++dt) {
                    const unsigned char* vb = kbase + ATT_VOFF + (dt * 32 + (lane & 31)) * 128;
#pragma unroll
                    for (int s2 = 0; s2 < 2; ++s2) {
                        const bf16x8 vf = *(const bf16x8*)(vb + (((sub * 4 + hf * 2 + s2) ^ fswz) << 4));
                        O[dt] = __builtin_amdgcn_mfma_f32_32x32x16_bf16(vf, pf[s2], O[dt], 0, 0, 0);
                    }
                }
            }
            cur = (cur == 2 * ATT_STAGE) ? 0 : cur + ATT_STAGE;
            nxt = (nxt == 2 * ATT_STAGE) ? 0 : nxt + ATT_STAGE;
        }
#undef ATT_STAGE_LOAD
        __syncthreads();
        float ltot = lrun + __shfl_xor(lrun, 32);
        {
            float* xo = (float*)lds + (size_t)w * (34 * 64) + lane;
            if (kh) {
#pragma unroll
                for (int i = 0; i < 16; ++i) { xo[i * 64] = O[0][i]; xo[(16 + i) * 64] = O[1][i]; }
            } else {
#pragma unroll
                for (int i = 0; i < 16; ++i) { xo[i * 64] = O[2][i]; xo[(16 + i) * 64] = O[3][i]; }
            }
            xo[32 * 64] = mrun; xo[33 * 64] = ltot;
            __syncthreads();
            const float* xi = (const float*)lds + (size_t)(w ^ 4) * (34 * 64) + lane;
            const float mp = xi[32 * 64], lp = xi[33 * 64];
            const float mn = fmaxf(mrun, mp);
            const float a0 = __builtin_amdgcn_exp2f(mrun - mn), a1 = __builtin_amdgcn_exp2f(mp - mn);
            ltot = ltot * a0 + lp * a1;
            if (kh) {
#pragma unroll
                for (int i = 0; i < 16; ++i) { O[2][i] = O[2][i] * a0 + xi[i * 64] * a1; O[3][i] = O[3][i] * a0 + xi[(16 + i) * 64] * a1; }
            } else {
#pragma unroll
                for (int i = 0; i < 16; ++i) { O[0][i] = O[0][i] * a0 + xi[i * 64] * a1; O[1][i] = O[1][i] * a0 + xi[(16 + i) * 64] * a1; }
            }
        }
        const float inv = 1.f / ltot;
        const bf16_t* gr = U + (size_t)qrow * INW + OFF_GMLA + h * 128;
        bf16_t* orow = MIX + (size_t)qrow * D + h * 128;
#define ATT_OUT(dt) do { _Pragma("unroll") for (int gq = 0; gq < 4; ++gq) { \
                const int d = (dt) * 32 + 8 * gq + 4 * hf; \
                const u32x2 gv = *(const u32x2*)(gr + d); \
                const float o0 = O[dt][4 * gq] * inv * silu(bflo(gv.x)), o1 = O[dt][4 * gq + 1] * inv * silu(bfhi(gv.x)); \
                const float o2 = O[dt][4 * gq + 2] * inv * silu(bflo(gv.y)), o3 = O[dt][4 * gq + 3] * inv * silu(bfhi(gv.y)); \
                u32x2 ov; ov.x = pk2(o0, o1); ov.y = pk2(o2, o3); \
                *(u32x2*)(orow + d) = ov; } } while (0)
        if (kh) { ATT_OUT(2); ATT_OUT(3); } else { ATT_OUT(0); ATT_OUT(1); }
#undef ATT_OUT
        __syncthreads();
    }
    {
        const int G = gridDim.x;
        const bool helpers = G > 128;
        const int hb = helpers ? (int)blockIdx.x - 128 : (int)blockIdx.x, nh = helpers ? G - 128 : G;
        if (hb >= 0) {
            for (int j = hb; j < 128; j += nh) mixer_pool_conv(j, l, lds);
            if (l == 0) {
                for (int j = hb; j < 352; j += nh) {
                    int tid = threadIdx.x; asm volatile("" : "+v"(tid));
                    unsigned char* ws = WSP();
                    const int kt = j / 22, nt = j % 22;
                    transpose_tile(IN(I_WIN) + (size_t)1024 * INW, INW, kt * 64, nt * 128, (bf16_t*)(ws + WS_WINT) + (size_t)INWP * 1024, 1024, nullptr, INW - nt * 128, (float*)lds, tid);
                }
            }
        }
    }
}

__device__ __forceinline__ void phase_e(const Params& p, int l, unsigned char* lds, const bool fused) {
    for (int it = blockIdx.x; it < 256; it += gridDim.x) {
        int tid = threadIdx.x; asm volatile("" : "+v"(tid));
        unsigned char* ws = WSP();
        const int w = tid >> 6, lane = tid & 63, wr = w >> 1, wc = w & 1, hf = lane >> 5;
        const int xi_ = it >> 3, m0 = ((it & 7) * 4 + (xi_ >> 3)) * 256, n0 = (xi_ & 7) * 128;
        float* dst = (l == 0) ? (float*)(ws + WS_X1) : OUTP();
        f32x16 acc[2][2];
        const int bidx = m0 < NCTX ? 0 : 1 + ((m0 - NCTX) >> 10);
        const float* gate = (const float*)(ws + WS_MOD) + (size_t)(l * 5 + bidx) * 3072 + 2048;
        const float* xin = (l == 0) ? (m0 < NCTX ? IN(I_XP) : IN(I_XS) - (size_t)NCTX * D) : (const float*)(ws + WS_X1);
        f32x16 xr[2][2];
#pragma unroll
        for (int nt = 0; nt < 2; ++nt)
#pragma unroll
            for (int mt = 0; mt < 2; ++mt)
#pragma unroll
                for (int i = 0; i < 16; ++i)
                    xr[mt][nt][i] = __builtin_nontemporal_load(xin + (size_t)(m0 + wr * 64 + mt * 32 + rowmap(i, hf)) * D + n0 + wc * 64 + nt * 32 + (lane & 31));
        gemm_mainloop<false>((const bf16_t*)(ws + WS_MIXED), 1024, (const bf16_t*)(ws + WS_WOUTT) + (size_t)l * 1024 * 1024, 1024, 1024, m0, n0, lds, acc, tid);
        int tid2 = tid; asm volatile("" : "+v"(tid2));
        const int w2 = tid2 >> 6, lane2 = tid2 & 63, wr2 = w2 >> 1, wc2 = w2 & 1, hf2 = lane2 >> 5;
#pragma unroll
        for (int nt = 0; nt < 2; ++nt) {
            const float gt = gate[n0 + wc2 * 64 + nt * 32 + (lane2 & 31)];
#pragma unroll
            for (int mt = 0; mt < 2; ++mt)
#pragma unroll
                for (int i = 0; i < 16; ++i) acc[mt][nt][i] = xr[mt][nt][i] + gt * acc[mt][nt][i];
        }
        if (!fused) {
#pragma unroll
            for (int nt = 0; nt < 2; ++nt) {
                const int n = n0 + wc2 * 64 + nt * 32 + (lane2 & 31);
#pragma unroll
                for (int mt = 0; mt < 2; ++mt)
#pragma unroll
                    for (int i = 0; i < 16; ++i) dst[(size_t)(m0 + wr2 * 64 + mt * 32 + rowmap(i, hf2)) * D + n] = acc[mt][nt][i];
            }
        } else {
            const int mtile = m0 >> 8, ntile = n0 >> 7;
            {
                float v[32];
#pragma unroll
                for (int mt = 0; mt < 2; ++mt)
#pragma unroll
                    for (int i = 0; i < 16; ++i) v[mt * 16 + i] = acc[mt][0][i] * acc[mt][0][i] + acc[mt][1][i] * acc[mt][1][i];
                const float tot = half_reduce32(v, lane2);
                const int j = lane2 & 31;
                ((float*)lds)[(wr2 * 64 + (j >> 4) * 32 + rowmap(j & 15, hf2)) * 2 + wc2] = tot;
            }
            __syncthreads();
            float* ssf = (float*)(ws + WS_SSF) + (size_t)(l * 32 + mtile) * 8 * 256;
            if (tid2 < 256) ssf[ntile * 256 + tid2] = ((const float*)lds)[2 * tid2] + ((const float*)lds)[2 * tid2 + 1];
            asm volatile("s_waitcnt vmcnt(0)" ::: "memory");
            __syncthreads();
            if (tid2 == 0) {
                unsigned* cnt = (unsigned*)(ws + WS_BAR) + XCHG_CNT + (l * 32 + mtile) * 8;
                __builtin_amdgcn_fence(__ATOMIC_RELEASE, "agent");
                asm volatile("s_waitcnt vmcnt(0)" ::: "memory");
                (void)xb_add(cnt, 1u);
                unsigned sp = 0u;
                while (xb_ld(cnt) < 8u) { __builtin_amdgcn_s_sleep(1); if (++sp > (1u << 22)) break; }
                __builtin_amdgcn_fence(__ATOMIC_ACQUIRE, "agent");
                asm volatile("s_waitcnt vmcnt(0)" ::: "memory");
            }
            __syncthreads();
            float* rsx = (float*)(lds + 4096);
            if (tid2 < 256) {
                float sacc = 0.f;
#pragma unroll
                for (int q = 0; q < 8; ++q) sacc += ssf[q * 256 + tid2];
                rsx[tid2] = rsqrtf(sacc * (1.f / 1024.f) + EPS);
            }
            __syncthreads();
            if (l == 0) {
                float* x1 = (float*)(ws + WS_X1);
                bf16_t* hn = (bf16_t*)(ws + WS_H);
                const float* mod1 = (const float*)(ws + WS_MOD) + (size_t)(5 + bidx) * 3072;
                const float* g1 = IN(I_GNORM) + D;
#pragma unroll
                for (int nt = 0; nt < 2; ++nt) {
                    const int n = n0 + wc2 * 64 + nt * 32 + (lane2 & 31);
                    const float a1 = g1[n] * (1.f + mod1[1024 + n]), sh1 = mod1[n];
#pragma unroll
                    for (int mt = 0; mt < 2; ++mt)
#pragma unroll
                        for (int i = 0; i < 16; ++i) {
                            const int r = wr2 * 64 + mt * 32 + rowmap(i, hf2);
                            const size_t o = (size_t)(m0 + r) * D + n;
                            const float x = acc[mt][nt][i];
                            __hip_atomic_store(&x1[o], x, __ATOMIC_RELAXED, __HIP_MEMORY_SCOPE_AGENT);
                            __hip_atomic_store(&hn[o], f2bf(x * rsx[r] * a1 + sh1), __ATOMIC_RELAXED, __HIP_MEMORY_SCOPE_AGENT);
                        }
                }
            } else {
                float* y = OUTP();
                const float* gf = IN(I_GFINAL);
#pragma unroll
                for (int nt = 0; nt < 2; ++nt) {
                    const int n = n0 + wc2 * 64 + nt * 32 + (lane2 & 31);
                    const float gfn = gf[n];
#pragma unroll
                    for (int mt = 0; mt < 2; ++mt)
#pragma unroll
                        for (int i = 0; i < 16; ++i) {
                            const int r = wr2 * 64 + mt * 32 + rowmap(i, hf2);
                            __builtin_nontemporal_store(acc[mt][nt][i] * rsx[r] * gfn, &y[(size_t)(m0 + r) * D + n]);
                        }
                }
            }
            __syncthreads();
        }
    }
}

__device__ __forceinline__ void phase_f(const Params& p, unsigned char* lds) {
    for (int it = blockIdx.x; it < 1024; it += gridDim.x) {
        int tid = threadIdx.x; asm volatile("" : "+v"(tid));
        const int w = tid >> 6, lane = tid & 63;
        const float* g = IN(I_GFINAL);
        float* x = OUTP() + (size_t)(it * 8 + w) * D;
        f32x4 v[4]; float ss = 0.f;
#pragma unroll
        for (int j = 0; j < 4; ++j) { v[j] = *(const f32x4*)(x + (lane + 64 * j) * 4); ss += v[j][0] * v[j][0] + v[j][1] * v[j][1] + v[j][2] * v[j][2] + v[j][3] * v[j][3]; }
#pragma unroll
        for (int o = 32; o >= 1; o >>= 1) ss += __shfl_xor(ss, o);
        const float rstd = rsqrtf(ss * (1.f / 1024.f) + EPS);
#pragma unroll
        for (int j = 0; j < 4; ++j) {
            const int k = (lane + 64 * j) * 4;
            const f32x4 gg = *(const f32x4*)(g + k);
            f32x4 o; o[0] = v[j][0] * rstd * gg[0]; o[1] = v[j][1] * rstd * gg[1]; o[2] = v[j][2] * rstd * gg[2]; o[3] = v[j][3] * rstd * gg[3];
            *(f32x4*)(x + k) = o;
        }
    }
}

constexpr int N_PHASES = 12;
#ifndef PHASE_MASK
#define PHASE_MASK 0xfff
#endif
__global__ void __launch_bounds__(NT) fwd_kernel(Params p) {
    __shared__ __attribute__((aligned(1024))) unsigned char lds[LDS_BYTES];
    if (p.use_cg) cg::this_grid().sync();
    if (threadIdx.x == 0) {
        volatile LAS unsigned long long* t = (volatile LAS unsigned long long*)(LAS unsigned char*)(lds + LDS_PTR);
#pragma unroll
        for (int i = 0; i < N_IN; ++i) t[i] = (unsigned long long)p.in[i];
        t[N_IN] = (unsigned long long)p.out; t[N_IN + 1] = (unsigned long long)p.ws;
    }
    __syncthreads();
    XcdBarrier xb;
    const bool multi = p.ph_hi > p.ph_lo;
    if (multi) {
        if (threadIdx.x == 0) { *(volatile LAS unsigned*)(LAS unsigned char*)(lds + LDS_XB) = 0u; *(volatile LAS unsigned*)(LAS unsigned char*)(lds + LDS_XB + 4) = 0u; }
        __syncthreads();
        xb = xcd_barrier_post((unsigned*)(p.ws + WS_BAR), (volatile LAS unsigned*)(LAS unsigned char*)(lds + LDS_XB));
    }
    const bool fused = multi && (gridDim.x == 256);
    const int lo = p.ph_lo, hi = fused ? 10 : p.ph_hi;
#ifndef REP_MASK
#define REP_MASK 0
#endif
#define RUN_PHASE(k, call) do { if ((PHASE_MASK & (1 << (k))) && lo <= (k) && (k) <= hi) { call; if (REP_MASK & (1 << (k))) { __syncthreads(); call; } if ((k) < hi) xcd_barrier(xb); } } while (0)
#define RUN_PHASE_NB(k, call) do { if ((PHASE_MASK & (1 << (k))) && lo <= (k) && (k) <= hi) { call; } } while (0)
    RUN_PHASE_NB(0, phase_p0(p, lds));
    RUN_PHASE(1, phase_a(p, 0, lds));
    RUN_PHASE_NB(2, phase_b(p, 0, lds));
    RUN_PHASE(3, phase_c(p, 0, lds));
    RUN_PHASE(4, phase_d(p, 0, lds));
    RUN_PHASE(5, phase_e(p, 0, lds, fused));
    if (!fused) RUN_PHASE(6, phase_a(p, 1, lds));
    RUN_PHASE_NB(7, phase_b(p, 1, lds));
    RUN_PHASE(8, phase_c(p, 1, lds));
    RUN_PHASE(9, phase_d(p, 1, lds));
    RUN_PHASE(10, phase_e(p, 1, lds, fused));
    RUN_PHASE(11, phase_f(p, lds));
#undef RUN_PHASE
}

extern "C" void kernel_launch(void* const* d_in, const int* in_sizes, int n_in, void* d_out, int out_size, void* d_ws, size_t ws_size, hipStream_t stream) {
    static int grid = 0;
    if (grid == 0) {
        int dev = 0, cus = 0, per_cu = 0;
        hipGetDevice(&dev);
        hipDeviceGetAttribute(&cus, hipDeviceAttributeMultiprocessorCount, dev);
        hipOccupancyMaxActiveBlocksPerMultiprocessor(&per_cu, (const void*)fwd_kernel, NT, 0);
        if (per_cu > 1) per_cu = 1;
        if (per_cu < 1) per_cu = 1;
        grid = cus * per_cu;
        if (n_in != N_IN || ws_size < WS_END) { fprintf(stderr, "kernel_launch: unexpected n_in %d / ws_size %zu\n", n_in, ws_size); }
    }
    Params p{};
    for (int i = 0; i < N_IN; ++i) p.in[i] = (const float*)d_in[i];
    p.out = (float*)d_out; p.ws = (unsigned char*)d_ws; p.use_cg = 0; p.pad = 0;
#if MK_MULTI
    for (int ph = 0; ph < N_PHASES; ++ph) {
        p.ph_lo = ph; p.ph_hi = ph;
        hipLaunchKernelGGL(fwd_kernel, dim3(grid), dim3(NT), 0, stream, p);
    }
#else
    hipMemsetAsync((unsigned char*)d_ws + WS_BAR, 0, 16384, stream);
    p.ph_lo = 0; p.ph_hi = N_PHASES - 1;
    void* args[] = {&p};
    hipError_t e = hipLaunchCooperativeKernel((const void*)fwd_kernel, dim3(grid), dim3(NT), args, 0, stream);
    if (e != hipSuccess) fprintf(stderr, "cooperative launch failed: %s (grid %d)\n", hipGetErrorString(e), grid);
#endif
}
```

```cpp
#include <hip/hip_runtime.h>
#include <hip/hip_cooperative_groups.h>
#include <stdint.h>
#include <stdio.h>
namespace cg = cooperative_groups;

#ifndef MK_MULTI
#define MK_MULTI 0
#endif

typedef unsigned short bf16_t;
typedef short bf16x8 __attribute__((ext_vector_type(8)));
typedef short bf16x4 __attribute__((ext_vector_type(4)));
typedef float f32x16 __attribute__((ext_vector_type(16)));
typedef float f32x4 __attribute__((ext_vector_type(4)));
typedef unsigned u32x4 __attribute__((ext_vector_type(4)));
typedef unsigned u32x2 __attribute__((ext_vector_type(2)));
#define LAS __attribute__((address_space(3)))

constexpr int D = 1024, INW = 2752, INWP = 2816, NTOK = 8192, NCTX = 4096;
constexpr int OFF_CKV = 384, OFF_KR = 640, OFF_GMLA = 704, OFF_PX = 1216, OFF_GPOOL = 1472, OFF_CB = 1728, OFF_CC = 1984, OFF_CH = 2240, OFF_GCONV = 2496;
constexpr int LKL = 1536, LKC = 256;
constexpr float EPS = 1e-6f;
constexpr float QSCALE = 0.07216878364870322f * 1.4426950408889634f;

enum { I_XP = 0, I_XS, I_CCKV, I_CKR, I_C, I_CCTX, I_WMOD, I_BMOD, I_GNORM, I_WIN, I_GQ, I_WUQ, I_GKV, I_WUKV, I_POOLW, I_POOLS, I_CONVW, I_WOUT, I_GFINAL, N_IN };

constexpr size_t WS_BAR = 0;
constexpr size_t WS_MOD = 16384;
constexpr size_t WS_COS = WS_MOD + 2 * 5 * 3072 * 4;
constexpr size_t WS_SIN = WS_COS + 1024 * 32 * 4;
constexpr size_t WS_WINT = WS_SIN + 1024 * 32 * 4;
constexpr size_t WS_WUQT = WS_WINT + (size_t)2 * INWP * 1024 * 2;
constexpr size_t WS_WUKVF = WS_WUQT + (size_t)2 * 768 * 384 * 2;
constexpr size_t WS_WUKVU = WS_WUKVF + (size_t)2 * 1024 * 256 * 2;
constexpr size_t WS_WOUTT = WS_WUKVU + (size_t)2 * 1024 * 256 * 2;
constexpr size_t WS_POOLWT = WS_WOUTT + (size_t)2 * 1024 * 1024 * 2;
constexpr size_t WS_CACHEA = WS_POOLWT + 2 * 4 * 64 * 64 * 2;
constexpr size_t WS_H = WS_CACHEA + (size_t)2 * 2048 * 256 * 2;
constexpr size_t WS_U = WS_H + (size_t)NTOK * 1024 * 2;
constexpr size_t WS_Q = WS_U + (size_t)NTOK * INW * 2;
constexpr size_t WS_KNL = WS_Q + (size_t)NTOK * 768 * 2;
constexpr size_t WS_VTL = WS_KNL + (size_t)2 * 16 * LKL * 128 * 2;
constexpr size_t WS_KRL = WS_VTL + (size_t)2 * 16 * LKL * 128 * 2;
constexpr size_t WS_KNC = WS_KRL + (size_t)2 * 4 * LKL * 64 * 2;
constexpr size_t WS_VTC = WS_KNC + (size_t)64 * LKC * 128 * 2;
constexpr size_t WS_KRC = WS_VTC + (size_t)64 * LKC * 128 * 2;
constexpr size_t WS_MIXED = WS_KRC + (size_t)16 * LKC * 64 * 2;
constexpr size_t WS_X1 = WS_MIXED + (size_t)NTOK * 1024 * 2;
constexpr size_t WS_SSP = WS_X1 + (size_t)NTOK * 1024 * 4;
constexpr size_t WS_SSF = WS_SSP + (size_t)NTOK * 16 * 4;
constexpr size_t WS_END = WS_SSF + (size_t)2 * 32 * 8 * 256 * 4;
constexpr int BC_CNT = 3456;
constexpr int MOD_CNT = 3457;
constexpr int XCHG_CNT = 3584;

constexpr int NT = 512;
constexpr int LDS_MAIN = 147456;
constexpr int LDS_BYTES = LDS_MAIN + 2048;
constexpr int LDS_RS = LDS_MAIN;
constexpr int LDS_XB = LDS_MAIN + 2032;
constexpr int LDS_PTR = LDS_MAIN + 1024;

struct Params {
    const float* in[N_IN];
    float* out;
    unsigned char* ws;
    int ph_lo, ph_hi, use_cg, pad;
};

__device__ __forceinline__ float bf2f(unsigned short h) { return __uint_as_float(((unsigned)h) << 16); }
__device__ __forceinline__ float bflo(unsigned w) { return __uint_as_float(w << 16); }
__device__ __forceinline__ float bfhi(unsigned w) { return __uint_as_float(w & 0xffff0000u); }
__device__ __forceinline__ unsigned pk2(float lo, float hi) { unsigned r; asm("v_cvt_pk_bf16_f32 %0, %1, %2" : "=v"(r) : "v"(lo), "v"(hi)); return r; }
__device__ __forceinline__ unsigned short f2bf(float f) { return (unsigned short)(pk2(f, 0.f) & 0xffffu); }
__device__ __forceinline__ float silu(float x) { return x / (1.f + __expf(-x)); }
__device__ __forceinline__ int rowmap(int i, int hf) { return (i & 3) + 8 * (i >> 2) + 4 * hf; }
__device__ __forceinline__ void unpack8(const u32x4& v, float (&f)[8]) {
    f[0] = bflo(v.x); f[1] = bfhi(v.x); f[2] = bflo(v.y); f[3] = bfhi(v.y); f[4] = bflo(v.z); f[5] = bfhi(v.z); f[6] = bflo(v.w); f[7] = bfhi(v.w);
}
__device__ __forceinline__ u32x4 pack8(const float (&f)[8]) { u32x4 r; r.x = pk2(f[0], f[1]); r.y = pk2(f[2], f[3]); r.z = pk2(f[4], f[5]); r.w = pk2(f[6], f[7]); return r; }


__device__ __forceinline__ unsigned char* lds_ptr(unsigned char* lds, int i) {
    volatile LAS unsigned* t = (volatile LAS unsigned*)(LAS unsigned char*)(lds + LDS_PTR);
    const unsigned lo = __builtin_amdgcn_readfirstlane(t[2 * i]), hi = __builtin_amdgcn_readfirstlane(t[2 * i + 1]);
    return (unsigned char*)(((unsigned long long)hi << 32) | (unsigned long long)lo);
}
#define IN(i) ((const float*)lds_ptr(lds, (i)))
#define OUTP() ((float*)lds_ptr(lds, N_IN))
#define WSP() (lds_ptr(lds, N_IN + 1))

#define XB_TMO      128
#define XB_XCNT(j)  (256  + 64 * (j))
#define XB_XSUB(j)  (1280 + 64 * (j))
#define XB_XGEN(j)  (2304 + 64 * (j))
#define XB_TOP      3328
#define XB_TOPGEN   3392
#define XCD_BAR_WORDS 3456
#define XB_SPIN_CAP (1u << 20)
__device__ __forceinline__ unsigned xb_ld(unsigned* p) { return __hip_atomic_load(p, __ATOMIC_RELAXED, __HIP_MEMORY_SCOPE_AGENT); }
__device__ __forceinline__ unsigned xb_add(unsigned* p, unsigned v) { return __hip_atomic_fetch_add(p, v, __ATOMIC_RELAXED, __HIP_MEMORY_SCOPE_AGENT); }
__device__ __forceinline__ unsigned xb_xcc_id() { return (unsigned)__builtin_amdgcn_s_getreg((3 << 11) | 20) & 0xFu; }
#define XB_SPIN(cond, bar) do { unsigned _sp = 0; while (cond) { __builtin_amdgcn_s_sleep(1); \
    if ((++_sp & 255u) == 0u) { if (xb_ld(&(bar)[XB_TMO])) break; if (_sp > XB_SPIN_CAP) { atomicAdd(&(bar)[XB_TMO], 1u); break; } } } } while (0)
struct XcdBarrier { unsigned* bar; unsigned x; volatile LAS unsigned* st; };
__device__ __forceinline__ XcdBarrier xcd_barrier_post(unsigned* bar, volatile LAS unsigned* st) {
    XcdBarrier b; b.bar = bar; b.x = xb_xcc_id(); b.st = st;
    if (threadIdx.x == 0) (void)xb_add(&bar[XB_XCNT(b.x)], 1u);
    return b;
}
__device__ __forceinline__ void xcd_barrier_complete(unsigned* bar, unsigned x, unsigned& nloc, unsigned& nx) {
    const unsigned G = gridDim.x * gridDim.y * gridDim.z;
    unsigned sum, cnt, mine, sp = 0u;
    for (;;) {
        sum = 0u; cnt = 0u; mine = 0u;
#pragma unroll
        for (unsigned j = 0; j < 16; ++j) { const unsigned c = xb_ld(&bar[XB_XCNT(j)]); sum += c; cnt += (c > 0u) ? 1u : 0u; mine = (j == x) ? c : mine; }
        if (sum == G) break;
        __builtin_amdgcn_s_sleep(1);
        if ((++sp & 255u) == 0u) { if (xb_ld(&bar[XB_TMO])) break; if (sp > XB_SPIN_CAP) { atomicAdd(&bar[XB_TMO], 1u); break; } }
    }
    nloc = mine > 0u ? mine : 1u; nx = cnt > 0u ? cnt : 1u;
}
__device__ __forceinline__ void xcd_barrier(const XcdBarrier& b) {
    asm volatile("s_waitcnt vmcnt(0)" ::: "memory");
    __syncthreads();
    if (threadIdx.x == 0) {
        unsigned* bar = b.bar;
        __builtin_amdgcn_s_waitcnt(0);
        unsigned nloc = b.st[0], nx = b.st[1];
        if (nloc == 0u) { xcd_barrier_complete(bar, b.x, nloc, nx); b.st[0] = nloc; b.st[1] = nx; }
        const unsigned old = xb_add(&bar[XB_XSUB(b.x)], 1u);
        const unsigned gen = old / nloc;
        if (old + 1u == (gen + 1u) * nloc) {
            __builtin_amdgcn_fence(__ATOMIC_RELEASE, "agent");
            asm volatile("s_waitcnt vmcnt(0)" ::: "memory");
            const unsigned og = xb_add(&bar[XB_TOP], 1u);
            const unsigned tg = og / nx;
            if (og + 1u == (tg + 1u) * nx) xb_add(&bar[XB_TOPGEN], 1u);
            else XB_SPIN(xb_ld(&bar[XB_TOPGEN]) == tg, bar);
            __builtin_amdgcn_fence(__ATOMIC_ACQUIRE, "agent");
            xb_add(&bar[XB_XGEN(b.x)], 1u);
            asm volatile("s_waitcnt vmcnt(0)" ::: "memory");
        } else {
            XB_SPIN(xb_ld(&bar[XB_XGEN(b.x)]) == gen, bar);
            __builtin_amdgcn_fence(__ATOMIC_ACQUIRE, "agent");
            asm volatile("s_waitcnt vmcnt(0)" ::: "memory");
        }
    }
    __syncthreads();
}

template <bool ROWSS>
__device__ __forceinline__ void gemm_mainloop(const bf16_t* __restrict__ A, int lda, const bf16_t* __restrict__ Bt, int ldb, int K, int m0, int n0,
                                              unsigned char* lds, f32x16 (&acc)[2][2], const int tid) {
    const int w = tid >> 6, lane = tid & 63, wr = w >> 1, wc = w & 1, hf = lane >> 5;
    const int srow = 8 * w + (lane >> 3);
    const int schunk = (lane & 7) ^ ((4 * w + (lane >> 4)) & 7);
    const bf16_t* pa = A + (size_t)(m0 + srow) * lda + schunk * 8;
    const bf16_t* pb = Bt + (size_t)(n0 + srow) * ldb + schunk * 8;
    const size_t a64 = (size_t)64 * lda, b64 = (size_t)64 * ldb;
    const int fswz = (lane >> 1) & 7;
    const int fa = (wr * 64 + (lane & 31)) * 128, fb = 32768 + (wc * 64 + (lane & 31)) * 128;
#pragma unroll
    for (int mt = 0; mt < 2; ++mt)
#pragma unroll
        for (int nt = 0; nt < 2; ++nt)
#pragma unroll
            for (int i = 0; i < 16; ++i) acc[mt][nt][i] = 0.f;
    const int nk = K >> 6;
#define GEMM_STAGE(boff, kt) do { \
        _Pragma("unroll") for (int i = 0; i < 4; ++i) \
            __builtin_amdgcn_global_load_lds((const unsigned*)(pa + i * a64 + (kt) * 64), (LAS unsigned*)(lds + (boff) + (8 * i + w) * 1024), 16, 0, 0); \
        _Pragma("unroll") for (int i = 0; i < 2; ++i) \
            __builtin_amdgcn_global_load_lds((const unsigned*)(pb + i * b64 + (kt) * 64), (LAS unsigned*)(lds + (boff) + 32768 + (8 * i + w) * 1024), 16, 0, 0); } while (0)
    GEMM_STAGE(0, 0); GEMM_STAGE(49152, 1);
    int cur = 0, nxt = 98304;
    for (int t = 0; t < nk; ++t) {
        if (t + 1 < nk) asm volatile("s_waitcnt vmcnt(6)" ::: "memory");
        else asm volatile("s_waitcnt vmcnt(0)" ::: "memory");
        __builtin_amdgcn_s_barrier();
        const unsigned char* base = lds + cur;
        bf16x8 fA0[2], fA1[2], fB0[2], fB1[2];
#define GEMM_LOADF(ks) do { const int sl = ((2 * (ks) + hf) ^ fswz) << 4; \
            fA0[(ks) & 1] = *(const bf16x8*)(base + fa + sl); fA1[(ks) & 1] = *(const bf16x8*)(base + fa + 32 * 128 + sl); \
            fB0[(ks) & 1] = *(const bf16x8*)(base + fb + sl); fB1[(ks) & 1] = *(const bf16x8*)(base + fb + 32 * 128 + sl); } while (0)
#define GEMM_MMA(ks) do { \
            acc[0][0] = __builtin_amdgcn_mfma_f32_32x32x16_bf16(fA0[(ks) & 1], fB0[(ks) & 1], acc[0][0], 0, 0, 0); \
            acc[0][1] = __builtin_amdgcn_mfma_f32_32x32x16_bf16(fA0[(ks) & 1], fB1[(ks) & 1], acc[0][1], 0, 0, 0); \
            acc[1][0] = __builtin_amdgcn_mfma_f32_32x32x16_bf16(fA1[(ks) & 1], fB0[(ks) & 1], acc[1][0], 0, 0, 0); \
            acc[1][1] = __builtin_amdgcn_mfma_f32_32x32x16_bf16(fA1[(ks) & 1], fB1[(ks) & 1], acc[1][1], 0, 0, 0); } while (0)
        GEMM_LOADF(0); GEMM_LOADF(1);
        __builtin_amdgcn_sched_barrier(0);
        if (t + 2 < nk) GEMM_STAGE(nxt, t + 2);
        __builtin_amdgcn_sched_barrier(0);
        GEMM_MMA(0); GEMM_LOADF(2);
        __builtin_amdgcn_sched_barrier(0);
        GEMM_MMA(1); GEMM_LOADF(3);
        __builtin_amdgcn_sched_barrier(0);
        GEMM_MMA(2);
        __builtin_amdgcn_sched_barrier(0);
        GEMM_MMA(3);
#undef GEMM_LOADF
#undef GEMM_MMA
        cur = (cur == 98304) ? 0 : cur + 49152;
        nxt = (nxt == 98304) ? 0 : nxt + 49152;
    }
#undef GEMM_STAGE
    __syncthreads();
}


__device__ __forceinline__ float half_reduce32(float (&v)[32], const int lane) {
#pragma unroll
    for (int k = 0; k < 5; ++k) {
        const bool b = (lane >> k) & 1;
        const int n = 16 >> k;
#pragma unroll
        for (int j = 0; j < n; ++j) {
            const float keep = b ? v[2 * j + 1] : v[2 * j];
            const float send = b ? v[2 * j] : v[2 * j + 1];
            v[j] = keep + __shfl_xor(send, 1 << k);
        }
    }
    return v[0];
}

__device__ __forceinline__ void epi_kv(const f32x16 (&acc)[2][2], int n0, bf16_t* kn, bf16_t* vt, int Lk, const float* rs, const int tid) {
    const int w = tid >> 6, lane = tid & 63, wr = w >> 1, wc = w & 1, hf = lane >> 5;
    const int nb = n0 + wc * 64;
    const int h = nb >> 8, within = nb & 255;
    if (within < 128) {
        bf16_t* base = kn + (size_t)h * Lk * 128;
#pragma unroll
        for (int mt = 0; mt < 2; ++mt)
#pragma unroll
            for (int i = 0; i < 16; ++i) {
                const int r = wr * 64 + mt * 32 + rowmap(i, hf);
                const float s = rs ? rs[r] : 1.f;
#pragma unroll
                for (int nt = 0; nt < 2; ++nt) base[(size_t)r * 128 + within + nt * 32 + (lane & 31)] = f2bf(acc[mt][nt][i] * s);
            }
    } else {
        bf16_t* base = vt + (size_t)h * 128 * Lk;
#pragma unroll
        for (int mt = 0; mt < 2; ++mt)
#pragma unroll
            for (int gq = 0; gq < 4; ++gq) {
                const int r = wr * 64 + mt * 32 + 8 * gq + 4 * hf;
                float s0 = 1.f, s1 = 1.f, s2 = 1.f, s3 = 1.f;
                if (rs) { s0 = rs[r]; s1 = rs[r + 1]; s2 = rs[r + 2]; s3 = rs[r + 3]; }
#pragma unroll
                for (int nt = 0; nt < 2; ++nt) {
                    const int d = within - 128 + nt * 32 + (lane & 31);
                    u32x2 v; v.x = pk2(acc[mt][nt][4 * gq] * s0, acc[mt][nt][4 * gq + 1] * s1); v.y = pk2(acc[mt][nt][4 * gq + 2] * s2, acc[mt][nt][4 * gq + 3] * s3);
                    *(u32x2*)(base + (size_t)d * Lk + (wr * 64 + mt * 32 + hf * 16 + gq * 4)) = v;
                }
            }
    }
}

__device__ __forceinline__ void transpose_tile(const float* __restrict__ src, int ldsrc, int k0, int n0, bf16_t* __restrict__ dst, int lddst, const float* __restrict__ gk, int nvalid, float* tile, const int tid, int nstore = 128) {
    {
        const int n = tid & 127, kq = tid >> 7;
        float v[16];
#pragma unroll
        for (int i = 0; i < 16; ++i) v[i] = (n < nvalid) ? __builtin_nontemporal_load(src + (size_t)(k0 + kq + 4 * i) * ldsrc + n0 + n) : 0.f;
#pragma unroll
        for (int i = 0; i < 16; ++i) {
            const int k = kq + 4 * i;
            tile[k * 129 + n] = gk ? v[i] * gk[k0 + k] : v[i];
        }
    }
    __syncthreads();
    const int nn = tid >> 2, kc = tid & 3;
    if (nn < nstore) {
#pragma unroll
        for (int j = 0; j < 2; ++j) {
            const int kb = (kc * 2 + j) * 8;
            float f[8];
#pragma unroll
            for (int q = 0; q < 8; ++q) f[q] = tile[(kb + q) * 129 + nn];
            *(u32x4*)(dst + (size_t)(n0 + nn) * lddst + k0 + kb) = pack8(f);
        }
    }
    __syncthreads();
}

__device__ __forceinline__ void phase_p0(const Params& p, unsigned char* lds) {
    constexpr int N_MOD = 192, N_WIN = 352, N_WUQ = 72, N_WUKV = 128, N_WOUT = 256, N_POOL = 8, N_ROPE = 64, N_CCKV = 256, N_CKR = 64;
    constexpr int E_MOD = N_MOD, E_WIN = E_MOD + N_WIN, E_WUQ = E_WIN + N_WUQ, E_WUKV = E_WUQ + N_WUKV, E_WOUT = E_WUKV + N_WOUT, E_POOL = E_WOUT + N_POOL,
                  E_ROPE = E_POOL + N_ROPE, E_CCKV = E_ROPE + N_CCKV, E_CKR = E_CCKV + N_CKR;
    float* tile = (float*)lds;
    for (int it = blockIdx.x; it < E_CKR; it += gridDim.x) {
        int tid = threadIdx.x; asm volatile("" : "+v"(tid));
        unsigned char* ws = WSP();
        if (it < E_MOD) {
            const int l = it / 96, cg0 = (it % 96) * 32;
            float* sc = (float*)lds;
            float* red = (float*)(lds + 20480);
            for (int e = tid; e < 5120; e += NT) {
                const int b = e >> 10, k = e & 1023;
                const float x = (b == 0) ? IN(I_CCTX)[k] : IN(I_C)[(b - 1) * 1024 + k];
                sc[e] = silu(x);
            }
            __syncthreads();
            const int kq = tid >> 3, c4 = tid & 7;
            const float* wm = IN(I_WMOD) + (size_t)l * 1024 * 3072 + cg0 + 4 * c4;
            f32x4 wv[16];
#pragma unroll
            for (int kk = 0; kk < 16; ++kk) wv[kk] = __builtin_nontemporal_load((const f32x4*)(wm + (size_t)(kq * 16 + kk) * 3072));
            f32x4 ab[5];
#pragma unroll
            for (int b = 0; b < 5; ++b) ab[b] = (f32x4){0.f, 0.f, 0.f, 0.f};
#pragma unroll
            for (int kk = 0; kk < 16; ++kk) {
                const int k = kq * 16 + kk;
#pragma unroll
                for (int b = 0; b < 5; ++b) { const float sv = sc[b * 1024 + k]; ab[b] += wv[kk] * sv; }
            }
#pragma unroll
            for (int b = 0; b < 5; ++b) *(f32x4*)(red + (kq * 5 + b) * 32 + 4 * c4) = ab[b];
            __syncthreads();
            if (tid < 160) {
                const int b = tid >> 5, c2 = tid & 31;
                float s = IN(I_BMOD)[l * 3072 + cg0 + c2];
#pragma unroll
                for (int q = 0; q < 64; ++q) s += red[(q * 5 + b) * 32 + c2];
                __hip_atomic_store(&((float*)(ws + WS_MOD))[(l * 5 + b) * 3072 + cg0 + c2], s, __ATOMIC_RELAXED, __HIP_MEMORY_SCOPE_AGENT);
            }
            asm volatile("s_waitcnt vmcnt(0)" ::: "memory");
            __syncthreads();
            if (tid == 0) (void)xb_add((unsigned*)(ws + WS_BAR) + MOD_CNT + 2 * l, 1u);
        } else if (it < E_WIN) {
            const int idx = it - E_MOD, l = idx / 352, rem = idx % 352, kt = rem / 22, nt = rem % 22;
            transpose_tile(IN(I_WIN) + (size_t)l * 1024 * INW, INW, kt * 64, nt * 128, (bf16_t*)(ws + WS_WINT) + (size_t)l * INWP * 1024, 1024, nullptr, INW - nt * 128, tile, tid);
        } else if (it < E_WUQ) {
            const int idx = it - E_WIN, l = idx / 36, rem = idx % 36, kt = rem / 6, nt = rem % 6;
            transpose_tile(IN(I_WUQ) + (size_t)l * 384 * 768, 768, kt * 64, nt * 128, (bf16_t*)(ws + WS_WUQT) + (size_t)l * 768 * 384, 384, IN(I_GQ) + l * 384, 128, tile, tid);
        } else if (it < E_WUKV) {
            const int idx = it - E_WUQ, l = idx / 64, rem = idx % 64, ver = rem / 32, r2 = rem % 32, kt = r2 / 8, nt = r2 % 8;
            transpose_tile(IN(I_WUKV) + (size_t)l * 256 * 1024, 1024, kt * 64, nt * 128, (bf16_t*)(ws + (ver ? WS_WUKVU : WS_WUKVF)) + (size_t)l * 1024 * 256, 256,
                           ver ? nullptr : IN(I_GKV) + l * 256, 128, tile, tid);
        } else if (it < E_WOUT) {
            const int idx = it - E_WUKV, l = idx / 128, rem = idx % 128, kt = rem / 8, nt = rem % 8;
            transpose_tile(IN(I_WOUT) + (size_t)l * 1024 * 1024, 1024, kt * 64, nt * 128, (bf16_t*)(ws + WS_WOUTT) + (size_t)l * 1024 * 1024, 1024, nullptr, 128, tile, tid);
        } else if (it < E_POOL) {
            const int idx = it - E_WOUT;
            transpose_tile(IN(I_POOLW) + (size_t)idx * 4096, 64, 0, 0, (bf16_t*)(ws + WS_POOLWT) + (size_t)idx * 4096, 64, nullptr, 64, tile, tid, 64);
        } else if (it < E_ROPE) {
            const int e = (it - E_POOL) * NT + tid, t = e >> 5, i = e & 31, f = i & 15;
            const float inv = exp2f(-(float)f * (13.287712379549449f / 16.0f));
            const float pos = (i < 16) ? (float)(t >> 6) : (float)(t & 63);
            const float ang = pos * inv;
            ((float*)(ws + WS_COS))[e] = cosf(ang);
            ((float*)(ws + WS_SIN))[e] = sinf(ang);
        } else if (it < E_CCKV) {
            const int e0 = (it - E_ROPE) * 4096 + tid * 8;
            const int c = e0 & 255, t = (e0 >> 8) & 511, l = (e0 >> 17) & 1, b = e0 >> 18;
            const f32x4 v0 = __builtin_nontemporal_load((const f32x4*)(IN(I_CCKV) + e0)), v1 = __builtin_nontemporal_load((const f32x4*)(IN(I_CCKV) + e0 + 4));
            u32x4 o; o.x = pk2(v0[0], v0[1]); o.y = pk2(v0[2], v0[3]); o.z = pk2(v1[0], v1[1]); o.w = pk2(v1[2], v1[3]);
            *(u32x4*)((bf16_t*)(ws + WS_CACHEA) + ((size_t)(l * 2048 + b * 512 + t)) * 256 + c) = o;
        } else {
            const int e0 = (it - E_CCKV) * 4096 + tid * 8;
            const int c = e0 & 63, t = (e0 >> 6) & 511, l = (e0 >> 15) & 1, b = e0 >> 16;
            const f32x4 v0 = __builtin_nontemporal_load((const f32x4*)(IN(I_CKR) + e0)), v1 = __builtin_nontemporal_load((const f32x4*)(IN(I_CKR) + e0 + 4));
            u32x4 o; o.x = pk2(v0[0], v0[1]); o.y = pk2(v0[2], v0[3]); o.z = pk2(v1[0], v1[1]); o.w = pk2(v1[2], v1[3]);
            *(u32x4*)((bf16_t*)(ws + WS_KRL) + ((size_t)((l * 4 + b) * LKL + t)) * 64 + c) = o;
        }
    }
}

__device__ __forceinline__ void phase_a(const Params& p, int l, unsigned char* lds) {
    const int n_gemm = 0;
    const int total = n_gemm + 256;
    if (l == 0) {
        int tid0 = threadIdx.x; asm volatile("" : "+v"(tid0));
        if (tid0 == 0) {
            unsigned* c = (unsigned*)(WSP() + WS_BAR) + MOD_CNT;
            unsigned sp = 0u;
            while (xb_ld(c) < 96u) { __builtin_amdgcn_s_sleep(1); if (++sp > (1u << 22)) break; }
            __builtin_amdgcn_fence(__ATOMIC_ACQUIRE, "agent");
            asm volatile("s_waitcnt vmcnt(0)" ::: "memory");
        }
        __syncthreads();
    }
    for (int it = blockIdx.x; it < total; it += gridDim.x) {
        int tid = threadIdx.x; asm volatile("" : "+v"(tid));
        unsigned char* ws = WSP();
        const int w = tid >> 6, lane = tid & 63;
        if (it < n_gemm) {
            const int ll = it >> 6, rem = it & 63, mt = rem >> 3, nt = rem & 7;
            f32x16 acc[2][2];
            const int m0 = mt * 256, n0 = nt * 128;
            gemm_mainloop<false>((const bf16_t*)(ws + WS_CACHEA) + (size_t)ll * 2048 * 256, 256, (const bf16_t*)(ws + WS_WUKVU) + (size_t)ll * 1024 * 256, 256, 256, m0, n0, lds, acc, tid);
            const int b = m0 >> 9, key0 = m0 & 511;
            bf16_t* kn = (bf16_t*)(ws + WS_KNL) + ((size_t)(ll * 16 + b * 4) * LKL + key0) * 128;
            bf16_t* vt = (bf16_t*)(ws + WS_VTL) + (size_t)(ll * 16 + b * 4) * 128 * LKL + key0;
            epi_kv(acc, n0, kn, vt, LKL, nullptr, tid);
        } else {
            f32x4 v[4][4];
#pragma unroll
            for (int r = 0; r < 4; ++r) {
                const int row = (it - n_gemm) * 32 + w * 4 + r;
                const float* x = (l == 0) ? (row < NCTX ? IN(I_XP) + (size_t)row * D : IN(I_XS) + (size_t)(row - NCTX) * D) : (const float*)(ws + WS_X1) + (size_t)row * D;
#pragma unroll
                for (int j = 0; j < 4; ++j) v[r][j] = *(const f32x4*)(x + (lane + 64 * j) * 4);
            }
            const float* g = IN(I_GNORM) + l * D;
#pragma unroll
            for (int r = 0; r < 4; ++r) {
                const int row = (it - n_gemm) * 32 + w * 4 + r;
                const int bidx = row < NCTX ? 0 : 1 + ((row - NCTX) >> 10);
                const float* mod = (const float*)(ws + WS_MOD) + (size_t)(l * 5 + bidx) * 3072;
                float ss = 0.f;
#pragma unroll
                for (int j = 0; j < 4; ++j) ss += v[r][j][0] * v[r][j][0] + v[r][j][1] * v[r][j][1] + v[r][j][2] * v[r][j][2] + v[r][j][3] * v[r][j][3];
#pragma unroll
                for (int o = 32; o >= 1; o >>= 1) ss += __shfl_xor(ss, o);
                const float rstd = rsqrtf(ss * (1.f / 1024.f) + EPS);
                bf16_t* hrow = (bf16_t*)(ws + WS_H) + (size_t)row * D;
#pragma unroll
                for (int j = 0; j < 4; ++j) {
                    const int k = (lane + 64 * j) * 4;
                    const f32x4 gg = *(const f32x4*)(g + k), sh = *(const f32x4*)(mod + k), sc = *(const f32x4*)(mod + 1024 + k);
                    float o0 = v[r][j][0] * rstd * gg[0] * (1.f + sc[0]) + sh[0], o1 = v[r][j][1] * rstd * gg[1] * (1.f + sc[1]) + sh[1];
                    float o2 = v[r][j][2] * rstd * gg[2] * (1.f + sc[2]) + sh[2], o3 = v[r][j][3] * rstd * gg[3] * (1.f + sc[3]) + sh[3];
                    u32x2 o; o.x = pk2(o0, o1); o.y = pk2(o2, o3);
                    *(u32x2*)(hrow + k) = o;
                }
            }
        }
    }
}

__device__ __forceinline__ void phase_b(const Params& p, int l, unsigned char* lds) {
    for (int it = blockIdx.x; it < 32 * 22 + 64; it += gridDim.x) {
        int tid = threadIdx.x; asm volatile("" : "+v"(tid));
        unsigned char* ws = WSP();
        bf16_t* U = (bf16_t*)(ws + WS_U);
        const int w = tid >> 6, lane = tid & 63, wr = w >> 1, wc = w & 1, hf = lane >> 5;
        if (it >= 704) {
            const int r = it - 704, m0 = (r >> 3) * 256, n0 = (r & 7) * 128;
            f32x16 acc[2][2];
            gemm_mainloop<false>((const bf16_t*)(ws + WS_CACHEA) + (size_t)l * 2048 * 256, 256, (const bf16_t*)(ws + WS_WUKVU) + (size_t)l * 1024 * 256, 256, 256, m0, n0, lds, acc, tid);
            const int b = m0 >> 9, key0 = m0 & 511;
            bf16_t* kn = (bf16_t*)(ws + WS_KNL) + ((size_t)(l * 16 + b * 4) * LKL + key0) * 128;
            bf16_t* vt = (bf16_t*)(ws + WS_VTL) + (size_t)(l * 16 + b * 4) * 128 * LKL + key0;
            epi_kv(acc, n0, kn, vt, LKL, nullptr, tid);
            continue;
        }
        int mt_, nt_;
        if (it < 192) { const int xi_ = it >> 3; mt_ = (it & 7) * 4 + xi_ / 6; nt_ = xi_ % 6; }
        else { const int j_ = it - 192, xi_ = j_ >> 3; mt_ = (j_ & 7) * 4 + (xi_ >> 4); nt_ = 6 + (xi_ & 15); }
        const int m0 = mt_ * 256, n0 = nt_ * 128;
        f32x16 acc[2][2];
        gemm_mainloop<false>((const bf16_t*)(ws + WS_H), 1024, (const bf16_t*)(ws + WS_WINT) + (size_t)l * INWP * 1024, 1024, 1024, m0, n0, lds, acc, tid);
#pragma unroll
        for (int nt = 0; nt < 2; ++nt) {
            const int n = n0 + wc * 64 + nt * 32 + (lane & 31);
            if (n < INW) {
#pragma unroll
                for (int mt = 0; mt < 2; ++mt)
#pragma unroll
                    for (int i = 0; i < 16; ++i) {
                        const int m = m0 + wr * 64 + mt * 32 + rowmap(i, hf);
                        U[(size_t)m * INW + n] = f2bf(acc[mt][nt][i]);
                    }
            }
        }
        if (nt_ < 5) {
            float v[32];
#pragma unroll
            for (int mt = 0; mt < 2; ++mt)
#pragma unroll
                for (int i = 0; i < 16; ++i) v[mt * 16 + i] = acc[mt][0][i] * acc[mt][0][i] + acc[mt][1][i] * acc[mt][1][i];
            const float tot = half_reduce32(v, lane);
            const int j = lane & 31;
            const int m = m0 + wr * 64 + (j >> 4) * 32 + rowmap(j & 15, hf);
            ((float*)(ws + WS_SSP))[(size_t)m * 16 + nt_ * 2 + wc] = tot;
        }
        if (nt_ < 6) {
            asm volatile("s_waitcnt vmcnt(0)" ::: "memory");
            __syncthreads();
            if (tid == 0) {
                __builtin_amdgcn_fence(__ATOMIC_RELEASE, "agent");
                asm volatile("s_waitcnt vmcnt(0)" ::: "memory");
                (void)xb_add((unsigned*)(ws + WS_BAR) + BC_CNT + (l * 32 + mt_) * 2, 1u);
            }
        }
    }
}

__device__ __forceinline__ void mixer_pool_conv(int item, int l, unsigned char* lds) {
        int tid = threadIdx.x; asm volatile("" : "+v"(tid));
        unsigned char* ws = WSP();
        const bf16_t* U = (const bf16_t*)(ws + WS_U);
        bf16_t* MIX = (bf16_t*)(ws + WS_MIXED);
        const int w = tid >> 6, lane = tid & 63, hf = lane >> 5;
        {
            const int R0 = item * 64;
            const bool ctx = R0 < NCTX;
            const int t0 = ctx ? (R0 & 255) : ((R0 - NCTX) & 1023);
            const int L = ctx ? 256 : 1024;
            const int rowbase = R0 - t0;
            {
                __syncthreads();
#pragma unroll
                for (int i = 0; i < 5; ++i) {
                    const int id = tid + NT * i, r = id >> 5, ck = id & 31, s = t0 - 8 + r;
                    u32x4 v = {0u, 0u, 0u, 0u};
                    if (s >= 0 && s < L) v = *(const u32x4*)(U + (size_t)(rowbase + s) * INW + OFF_PX + ck * 8);
                    *(u32x4*)(lds + r * 528 + ck * 16) = v;
                }
                __syncthreads();
                const int g = w & 3, th = w >> 2, half = 1 << g;
                const int tok = th * 32 + (lane & 31), t = t0 + tok;
                const int lo = max(t - half, 0), hi = min(t + half, L);
                const float rc = 1.f / (float)(hi - lo);
                bf16x8 af[4];
                {
                    float sum[4][8];
#pragma unroll
                    for (int ks = 0; ks < 4; ++ks)
#pragma unroll
                        for (int q = 0; q < 8; ++q) sum[ks][q] = 0.f;
                    const unsigned char* pb = lds + (tok + 8) * 528 + g * 128 + hf * 16;
#pragma unroll 2
                    for (int d = -half; d < half; ++d) {
#pragma unroll
                        for (int ks = 0; ks < 4; ++ks) {
                            const u32x4 v = *(const u32x4*)(pb + d * 528 + ks * 32);
                            float f[8]; unpack8(v, f);
#pragma unroll
                            for (int q = 0; q < 8; ++q) sum[ks][q] += f[q];
                        }
                    }
#pragma unroll
                    for (int ks = 0; ks < 4; ++ks) {
                        const u32x4 sv = *(const u32x4*)(pb + ks * 32);
                        float f[8]; unpack8(sv, f);
#pragma unroll
                        for (int q = 0; q < 8; ++q) sum[ks][q] = sum[ks][q] * rc - f[q];
                        const u32x4 pk = pack8(sum[ks]);
                        af[ks] = *(const bf16x8*)&pk;
                    }
                }
                const bf16_t* pw = (const bf16_t*)(ws + WS_POOLWT) + (size_t)(l * 4 + g) * 4096;
                f32x16 pacc[2];
#pragma unroll
                for (int nt = 0; nt < 2; ++nt) {
#pragma unroll
                    for (int i = 0; i < 16; ++i) pacc[nt][i] = 0.f;
#pragma unroll
                    for (int ks = 0; ks < 4; ++ks) {
                        const bf16x8 bfr = *(const bf16x8*)(pw + (nt * 32 + (lane & 31)) * 64 + 16 * ks + 8 * hf);
                        pacc[nt] = __builtin_amdgcn_mfma_f32_32x32x16_bf16(af[ks], bfr, pacc[nt], 0, 0, 0);
                    }
                }
#pragma unroll
                for (int nt = 0; nt < 2; ++nt) {
                    const int ch = g * 64 + nt * 32 + (lane & 31);
                    const float ps = IN(I_POOLS)[l * 256 + ch];
#pragma unroll
                    for (int i = 0; i < 16; ++i) {
                        const int row = R0 + th * 32 + rowmap(i, hf);
                        const float gp = bf2f(U[(size_t)row * INW + OFF_GPOOL + ch]);
                        MIX[(size_t)row * D + 512 + ch] = f2bf(pacc[nt][i] * ps * silu(gp));
                    }
                }
            }
            {
                const float* cw = IN(I_CONVW) + l * 768;
#pragma unroll 2
                for (int i = 0; i < 4; ++i) {
                    const int id = tid + NT * i, tt = id >> 5, c0 = (id & 31) * 8, t = t0 + tt;
                    const bf16_t* ur = U + (size_t)(rowbase + t) * INW;
                    const u32x4 zero4 = {0u, 0u, 0u, 0u};
                    const u32x4 ccm = (t > 0) ? *(const u32x4*)(ur - INW + OFF_CC + c0) : zero4, chm = (t > 0) ? *(const u32x4*)(ur - INW + OFF_CH + c0) : zero4;
                    const u32x4 cc0 = *(const u32x4*)(ur + OFF_CC + c0), ch0 = *(const u32x4*)(ur + OFF_CH + c0);
                    const u32x4 ccp = (t + 1 < L) ? *(const u32x4*)(ur + INW + OFF_CC + c0) : zero4, chp = (t + 1 < L) ? *(const u32x4*)(ur + INW + OFF_CH + c0) : zero4;
                    const u32x4 cbv = *(const u32x4*)(ur + OFF_CB + c0), gcv = *(const u32x4*)(ur + OFF_GCONV + c0);
                    float a[8], b2[8], zm[8], z0[8], zp[8], cb[8], gc[8], o[8];
                    unpack8(ccm, a); unpack8(chm, b2);
#pragma unroll
                    for (int q = 0; q < 8; ++q) zm[q] = a[q] * b2[q];
                    unpack8(cc0, a); unpack8(ch0, b2);
#pragma unroll
                    for (int q = 0; q < 8; ++q) z0[q] = a[q] * b2[q];
                    unpack8(ccp, a); unpack8(chp, b2);
#pragma unroll
                    for (int q = 0; q < 8; ++q) zp[q] = a[q] * b2[q];
                    unpack8(cbv, cb); unpack8(gcv, gc);
#pragma unroll
                    for (int q = 0; q < 8; ++q) {
                        const float cv = zm[q] * cw[c0 + q] + z0[q] * cw[256 + c0 + q] + zp[q] * cw[512 + c0 + q];
                        o[q] = cb[q] * cv * silu(gc[q]);
                    }
                    *(u32x4*)(MIX + (size_t)(rowbase + t) * D + 768 + c0) = pack8(o);
                }
            }
        }
        __syncthreads();
}

__device__ __forceinline__ void bc_wait_all(unsigned char* lds, int l) {
    int tid = threadIdx.x; asm volatile("" : "+v"(tid));
    unsigned char* ws = WSP();
    if (tid < 64) {
        if (tid < 32) {
            unsigned* c = (unsigned*)(ws + WS_BAR) + BC_CNT + (l * 32 + tid) * 2;
            unsigned sp = 0u;
            while (xb_ld(c) < 6u) { __builtin_amdgcn_s_sleep(1); if (++sp > (1u << 22)) break; }
        }
        __builtin_amdgcn_fence(__ATOMIC_ACQUIRE, "agent");
        asm volatile("s_waitcnt vmcnt(0)" ::: "memory");
    }
    __syncthreads();
}

__device__ __forceinline__ void phase_c(const Params& p, int l, unsigned char* lds) {
    constexpr int N_C3 = 128, N_C2 = 256, N_C1 = 192;
    bc_wait_all(lds, l);
    const bool bal = (gridDim.x == 256);
    const int bid_ = blockIdx.x;
    int li0, li1, li2, nli;
    if (bid_ >= 192) { const int k = bid_ - 192; li0 = N_C3 + k; li1 = N_C3 + 64 + k; li2 = N_C3 + N_C2 + k; nli = 3; }
    else if (bid_ >= 128) { const int j = bid_ - 128; li0 = N_C3 + 128 + j; li1 = N_C3 + 192 + j; li2 = 0; nli = 2; }
    else { li0 = N_C3 + N_C2 + 64 + bid_; li1 = bid_; li2 = 0; nli = 2; }
    for (int q_ = 0; ; ++q_) {
        int it;
        if (bal) { if (q_ >= nli) break; it = (q_ == 0) ? li0 : ((q_ == 1) ? li1 : li2); }
        else { const int it_ = bid_ + q_ * (int)gridDim.x; if (it_ >= N_C3 + N_C2 + N_C1) break; it = it_ < N_C2 + N_C1 ? it_ + N_C3 : it_ - (N_C2 + N_C1); }
        int tid = threadIdx.x; asm volatile("" : "+v"(tid));
        unsigned char* ws = WSP();
        const bf16_t* U = (const bf16_t*)(ws + WS_U);
        bf16_t* MIX = (bf16_t*)(ws + WS_MIXED);
        const float* costab = (const float*)(ws + WS_COS);
        const float* sintab = (const float*)(ws + WS_SIN);
        const int w = tid >> 6, lane = tid & 63, wr = w >> 1, wc = w & 1, hf = lane >> 5;
#ifndef C_MASK
#define C_MASK 7
#endif
        if (it < N_C3) { if (C_MASK & 1) {
            const int R0 = it * 64;
            const bool ctx = R0 < NCTX;
            const int b = ctx ? (R0 >> 8) : ((R0 - NCTX) >> 10);
            const int t0 = ctx ? (R0 & 255) : ((R0 - NCTX) & 1023);
            const int L = ctx ? 256 : 1024;
            const int rowbase = R0 - t0;
            {
                const int tok = tid >> 3, sub = tid & 7, row = R0 + tok, t = t0 + tok;
                const bf16_t* ur = U + (size_t)row * INW;
                u32x4 cv[4]; float ss = 0.f;
#pragma unroll
                for (int j = 0; j < 4; ++j) {
                    cv[j] = *(const u32x4*)(ur + OFF_CKV + sub * 32 + j * 8);
                    float f[8]; unpack8(cv[j], f);
#pragma unroll
                    for (int q = 0; q < 8; ++q) ss += f[q] * f[q];
                }
                ss += __shfl_xor(ss, 1); ss += __shfl_xor(ss, 2); ss += __shfl_xor(ss, 4);
                const float rstd = rsqrtf(ss * (1.f / 256.f) + EPS);
                const u32x4 kv = *(const u32x4*)(ur + OFF_KR + sub * 8);
                float kf[8]; unpack8(kv, kf);
                if (ctx) {
                    float* oc = OUTP() + (size_t)2 * NCTX * D + ((size_t)((b * 2 + l) * 256 + t)) * 256 + sub * 32;
                    const float* gk = IN(I_GKV) + l * 256 + sub * 32;
#pragma unroll
                    for (int j = 0; j < 4; ++j) {
                        float f[8]; unpack8(cv[j], f);
                        f32x4 o0, o1;
#pragma unroll
                        for (int q = 0; q < 4; ++q) { o0[q] = f[q] * rstd * gk[j * 8 + q]; o1[q] = f[4 + q] * rstd * gk[j * 8 + 4 + q]; }
                        *(f32x4*)(oc + j * 8) = o0; *(f32x4*)(oc + j * 8 + 4) = o1;
                    }
                    float* ok = OUTP() + (size_t)2 * NCTX * D + (size_t)16 * 2 * 256 * 256 + ((size_t)((b * 2 + l) * 256 + t)) * 64 + sub * 8;
                    f32x4 k0, k1;
#pragma unroll
                    for (int q = 0; q < 4; ++q) { k0[q] = kf[q]; k1[q] = kf[4 + q]; }
                    *(f32x4*)ok = k0; *(f32x4*)(ok + 4) = k1;
                    *(u32x4*)((bf16_t*)(ws + WS_KRC) + ((size_t)(b * LKC + t)) * 64 + sub * 8) = kv;
                } else {
                    float o[8];
                    const int ib = (sub & 3) * 8;
#pragma unroll
                    for (int q = 0; q < 8; ++q) {
                        const float other = __shfl_xor(kf[q], 4);
                        const float cs = costab[t * 32 + ib + q], sn = sintab[t * 32 + ib + q];
                        o[q] = (sub < 4) ? (kf[q] * cs - other * sn) : (kf[q] * cs + other * sn);
                    }
                    *(u32x4*)((bf16_t*)(ws + WS_KRL) + ((size_t)((l * 4 + b) * LKL + 512 + t)) * 64 + sub * 8) = pack8(o);
                }
            }
        } } else if (it < N_C3 + N_C2) { if (C_MASK & 2) {
            const int idx = it - N_C3, xi_ = idx >> 3, mt_ = (idx & 7) * 4 + (xi_ >> 3), nt_ = xi_ & 7, m0 = mt_ * 256, n0 = nt_ * 128;
            f32x16 acc[2][2];
            __syncthreads();
            if (tid < 256) {
                const float* sp = (const float*)(ws + WS_SSP) + (size_t)(m0 + tid) * 16;
                ((float*)(lds + LDS_RS))[tid] = rsqrtf(((sp[6] + sp[7]) + (sp[8] + sp[9])) * (1.f / 256.f) + EPS);
            }
            gemm_mainloop<false>(U + OFF_CKV, INW, (const bf16_t*)(ws + WS_WUKVF) + (size_t)l * 1024 * 256, 256, 256, m0, n0, lds, acc, tid);
            bf16_t *kn, *vt; int Lk;
            if (m0 < NCTX) {
                const int b = m0 >> 8, key0 = m0 & 255; Lk = LKC;
                kn = (bf16_t*)(ws + WS_KNC) + ((size_t)(b * 4) * LKC + key0) * 128;
                vt = (bf16_t*)(ws + WS_VTC) + (size_t)(b * 4) * 128 * LKC + key0;
            } else {
                const int b = (m0 - NCTX) >> 10, key0 = 512 + ((m0 - NCTX) & 1023); Lk = LKL;
                kn = (bf16_t*)(ws + WS_KNL) + ((size_t)(l * 16 + b * 4) * LKL + key0) * 128;
                vt = (bf16_t*)(ws + WS_VTL) + (size_t)(l * 16 + b * 4) * 128 * LKL + key0;
            }
            epi_kv(acc, n0, kn, vt, Lk, (const float*)(lds + LDS_RS), tid);
        } } else { if (C_MASK & 4) {
            const int idx = it - N_C3 - N_C2, xi_ = idx >> 3, mt_ = (idx & 7) * 4 + xi_ / 6, nt_ = xi_ % 6, m0 = mt_ * 256, n0 = nt_ * 128;
            f32x16 acc[2][2];
            __syncthreads();
            if (tid < 256) {
                const float* sp = (const float*)(ws + WS_SSP) + (size_t)(m0 + tid) * 16;
                ((float*)(lds + LDS_RS))[tid] = rsqrtf((((sp[0] + sp[1]) + (sp[2] + sp[3])) + (sp[4] + sp[5])) * (1.f / 384.f) + EPS);
            }
            gemm_mainloop<false>(U, INW, (const bf16_t*)(ws + WS_WUQT) + (size_t)l * 768 * 384, 384, 384, m0, n0, lds, acc, tid);
            const float* rs = (const float*)(lds + LDS_RS);
            bf16_t* Q = (bf16_t*)(ws + WS_Q);
            const int nb = n0 + wc * 64;
            const bool rope = ((nb >> 6) % 3 == 2) && (m0 >= NCTX);
#pragma unroll
            for (int mt = 0; mt < 2; ++mt)
#pragma unroll
                for (int i = 0; i < 16; ++i) {
                    const int r = wr * 64 + mt * 32 + rowmap(i, hf), m = m0 + r;
                    const float s = rs[r] * QSCALE;
                    float v0 = acc[mt][0][i] * s, v1 = acc[mt][1][i] * s;
                    if (rope) {
                        const int t = (m - NCTX) & 1023;
                        const float cs = costab[t * 32 + (lane & 31)], sn = sintab[t * 32 + (lane & 31)];
                        const float o0 = v0 * cs - v1 * sn, o1 = v1 * cs + v0 * sn;
                        v0 = o0; v1 = o1;
                    }
                    Q[(size_t)m * 768 + nb + (lane & 31)] = f2bf(v0);
                    Q[(size_t)m * 768 + nb + 32 + (lane & 31)] = f2bf(v1);
                }
        } }
    }
}

constexpr int ATT_STAGE = 40960, ATT_VOFF = 24576;
__device__ __forceinline__ void phase_d(const Params& p, int l, unsigned char* lds) {
    for (int it = blockIdx.x; it < 256; it += gridDim.x) {
        int tid = threadIdx.x; asm volatile("" : "+v"(tid));
        unsigned char* ws = WSP();
        const bf16_t* U = (const bf16_t*)(ws + WS_U);
        const bf16_t* Q = (const bf16_t*)(ws + WS_Q);
        bf16_t* MIX = (bf16_t*)(ws + WS_MIXED);
        const int w = tid >> 6, lane = tid & 63, hf = lane >> 5;
        const int qh = w & 3, kh = w >> 2;
        const int fswz = (lane >> 1) & 7;
        int h, Lk, rowq0; const bf16_t *Kn, *Vt, *Kr;
        if (it < 128) {
            const int xs_ = it >> 3, bh_ = (it & 7) * 2 + (xs_ >> 3), b = bh_ >> 2, qb = xs_ & 7; h = bh_ & 3;   Lk = LKL; rowq0 = NCTX + b * 1024 + qb * 128;
            Kn = (const bf16_t*)(ws + WS_KNL) + (size_t)(l * 16 + b * 4 + h) * LKL * 128;
            Vt = (const bf16_t*)(ws + WS_VTL) + (size_t)(l * 16 + b * 4 + h) * 128 * LKL;
            Kr = (const bf16_t*)(ws + WS_KRL) + (size_t)(l * 4 + b) * LKL * 64;
        } else {
            const int j = it - 128, xs_ = j >> 3, bh_ = (j & 7) * 8 + (xs_ >> 1), b = bh_ >> 2, qb = xs_ & 1; h = bh_ & 3; Lk = LKC; rowq0 = b * 256 + qb * 128;
            Kn = (const bf16_t*)(ws + WS_KNC) + (size_t)(b * 4 + h) * LKC * 128;
            Vt = (const bf16_t*)(ws + WS_VTC) + (size_t)(b * 4 + h) * 128 * LKC;
            Kr = (const bf16_t*)(ws + WS_KRC) + (size_t)b * LKC * 64;
        }
        const int qrow = rowq0 + qh * 32 + (lane & 31);
        bf16x8 qf[12];
#pragma unroll
        for (int ks = 0; ks < 12; ++ks) qf[ks] = *(const bf16x8*)(Q + (size_t)qrow * 768 + h * 192 + 16 * ks + 8 * hf);
        f32x16 O[4];
#pragma unroll
        for (int dt = 0; dt < 4; ++dt)
#pragma unroll
            for (int i = 0; i < 16; ++i) O[dt][i] = 0.f;
        float mrun = -1e30f, lrun = 0.f;
        const int srow = 8 * w + (lane >> 3);
        const int schunk = (lane & 7) ^ ((4 * w + (lane >> 4)) & 7);
        const bf16_t* pkn = Kn + (size_t)srow * 128 + schunk * 8;
        const bf16_t* pkr = Kr + (size_t)srow * 64 + schunk * 8;
        const bf16_t* pv = Vt + (size_t)srow * Lk + schunk * 8;
        const size_t v64 = (size_t)64 * Lk;
        const int nsteps = Lk >> 6;
#define ATT_STAGE_LOAD(boff, st) do { const int key0 = (st) * 64; \
        __builtin_amdgcn_global_load_lds((const unsigned*)(pkn + (size_t)key0 * 128), (LAS unsigned*)(lds + (boff) + w * 1024), 16, 0, 0); \
        __builtin_amdgcn_global_load_lds((const unsigned*)(pkn + (size_t)key0 * 128 + 64), (LAS unsigned*)(lds + (boff) + (8 + w) * 1024), 16, 0, 0); \
        __builtin_amdgcn_global_load_lds((const unsigned*)(pkr + (size_t)key0 * 64), (LAS unsigned*)(lds + (boff) + (16 + w) * 1024), 16, 0, 0); \
        __builtin_amdgcn_global_load_lds((const unsigned*)(pv + key0), (LAS unsigned*)(lds + (boff) + ATT_VOFF + w * 1024), 16, 0, 0); \
        __builtin_amdgcn_global_load_lds((const unsigned*)(pv + v64 + key0), (LAS unsigned*)(lds + (boff) + ATT_VOFF + (8 + w) * 1024), 16, 0, 0); } while (0)
        ATT_STAGE_LOAD(0, 0); ATT_STAGE_LOAD(ATT_STAGE, 1);
        int cur = 0, nxt = 2 * ATT_STAGE;
        for (int st = 0; st < nsteps; ++st) {
            if (st + 1 < nsteps) asm volatile("s_waitcnt vmcnt(5)" ::: "memory");
            else asm volatile("s_waitcnt vmcnt(0)" ::: "memory");
            __builtin_amdgcn_s_barrier();
            const unsigned char* kbase = lds + cur;
            {
                const int sub = kh;
                f32x16 S;
#pragma unroll
                for (int i = 0; i < 16; ++i) S[i] = 0.f;
                const unsigned char* kb = kbase + (sub * 32 + (lane & 31)) * 128;
                {
                    const bf16x8 kf0 = *(const bf16x8*)(kb + (((0 + hf) ^ fswz) << 4));
                    const bf16x8 kf1 = *(const bf16x8*)(kb + (((2 + hf) ^ fswz) << 4));
                    __builtin_amdgcn_sched_barrier(0);
                    if (st + 2 < nsteps) ATT_STAGE_LOAD(nxt, st + 2);
                    __builtin_amdgcn_sched_barrier(0);
                    S = __builtin_amdgcn_mfma_f32_32x32x16_bf16(kf0, qf[0], S, 0, 0, 0);
                    S = __builtin_amdgcn_mfma_f32_32x32x16_bf16(kf1, qf[1], S, 0, 0, 0);
                }
#pragma unroll
                for (int ks = 2; ks < 12; ++ks) {
                    const bf16x8 kf = *(const bf16x8*)(kb + (ks >> 2) * 8192 + (((2 * (ks & 3) + hf) ^ fswz) << 4));
                    S = __builtin_amdgcn_mfma_f32_32x32x16_bf16(kf, qf[ks], S, 0, 0, 0);
                }
                float tmax = S[0];
#pragma unroll
                for (int i = 1; i < 16; ++i) tmax = fmaxf(tmax, S[i]);
                tmax = fmaxf(tmax, __shfl_xor(tmax, 32));
                if (__builtin_amdgcn_ballot_w64(tmax > mrun + 8.f) != 0ull) {
                    const float mnew = fmaxf(mrun, tmax);
                    const float alpha = __builtin_amdgcn_exp2f(mrun - mnew);
                    mrun = mnew;
                    lrun *= alpha;
#pragma unroll
                    for (int dt = 0; dt < 4; ++dt)
#pragma unroll
                        for (int i = 0; i < 16; ++i) O[dt][i] *= alpha;
                }
                float psum = 0.f;
#pragma unroll
                for (int i = 0; i < 16; ++i) { S[i] = __builtin_amdgcn_exp2f(S[i] - mrun); psum += S[i]; }
                lrun += psum;
                bf16x8 pf[2];
#pragma unroll
                for (int s2 = 0; s2 < 2; ++s2) {
                    u32x4 pk; pk.x = pk2(S[8 * s2], S[8 * s2 + 1]); pk.y = pk2(S[8 * s2 + 2], S[8 * s2 + 3]); pk.z = pk2(S[8 * s2 + 4], S[8 * s2 + 5]); pk.w = pk2(S[8 * s2 + 6], S[8 * s2 + 7]);
                    pf[s2] = *(const bf16x8*)&pk;
                }
#pragma unroll
                for (int dt = 0; dt < 4; ++dt) {
                    const unsigned char* vb = kbase + ATT_VOFF + (dt * 32 + (lane & 31)) * 128;
#pragma unroll
                    for (int s2 = 0; s2 < 2; ++s2) {
                        const bf16x8 vf = *(const bf16x8*)(vb + (((sub * 4 + hf * 2 + s2) ^ fswz) << 4));
                        O[dt] = __builtin_amdgcn_mfma_f32_32x32x16_bf16(vf, pf[s2], O[dt], 0, 0, 0);
                    }
                }
            }
            cur = (cur == 2 * ATT_STAGE) ? 0 : cur + ATT_STAGE;
            nxt = (nxt == 2 * ATT_STAGE) ? 0 : nxt + ATT_STAGE;
        }
#undef ATT_STAGE_LOAD
        __syncthreads();
        float ltot = lrun + __shfl_xor(lrun, 32);
        {
            float* xo = (float*)lds + (size_t)w * (34 * 64) + lane;
            if (kh) {
#pragma unroll
                for (int i = 0; i < 16; ++i) { xo[i * 64] = O[0][i]; xo[(16 + i) * 64] = O[1][i]; }
            } else {
#pragma unroll
                for (int i = 0; i < 16; ++i) { xo[i * 64] = O[2][i]; xo[(16 + i) * 64] = O[3][i]; }
            }
            xo[32 * 64] = mrun; xo[33 * 64] = ltot;
            __syncthreads();
            const float* xi = (const float*)lds + (size_t)(w ^ 4) * (34 * 64) + lane;
            const float mp = xi[32 * 64], lp = xi[33 * 64];
            const float mn = fmaxf(mrun, mp);
            const float a0 = __builtin_amdgcn_exp2f(mrun - mn), a1 = __builtin_amdgcn_exp2f(mp - mn);
            ltot = ltot * a0 + lp * a1;
            if (kh) {
#pragma unroll
                for (int i = 0; i < 16; ++i) { O[2][i] = O[2][i] * a0 + xi[i * 64] * a1; O[3][i] = O[3][i] * a0 + xi[(16 + i) * 64] * a1; }
            } else {
#pragma unroll
                for (int i = 0; i < 16; ++i) { O[0][i] = O[0][i] * a0 + xi[i * 64] * a1; O[1][i] = O[1][i] * a0 + xi[(16 + i) * 64] * a1; }
            }
        }
        const float inv = 1.f / ltot;
        const bf16_t* gr = U + (size_t)qrow * INW + OFF_GMLA + h * 128;
        bf16_t* orow = MIX + (size_t)qrow * D + h * 128;
#define ATT_OUT(dt) do { _Pragma("unroll") for (int gq = 0; gq < 4; ++gq) { \
                const int d = (dt) * 32 + 8 * gq + 4 * hf; \
                const u32x2 gv = *(const u32x2*)(gr + d); \
                const float o0 = O[dt][4 * gq] * inv * silu(bflo(gv.x)), o1 = O[dt][4 * gq + 1] * inv * silu(bfhi(gv.x)); \
                const float o2 = O[dt][4 * gq + 2] * inv * silu(bflo(gv.y)), o3 = O[dt][4 * gq + 3] * inv * silu(bfhi(gv.y)); \
                u32x2 ov; ov.x = pk2(o0, o1); ov.y = pk2(o2, o3); \
                *(u32x2*)(orow + d) = ov; } } while (0)
        if (kh) { ATT_OUT(2); ATT_OUT(3); } else { ATT_OUT(0); ATT_OUT(1); }
#undef ATT_OUT
        __syncthreads();
    }
    {
        const int G = gridDim.x;
        const bool helpers = G > 128;
        const int hb = helpers ? (int)blockIdx.x - 128 : (int)blockIdx.x, nh = helpers ? G - 128 : G;
        if (hb >= 0) {
            for (int j = hb; j < 128; j += nh) mixer_pool_conv(j, l, lds);
            if (l == 0) {
                for (int j = hb; j < 352; j += nh) {
                    int tid = threadIdx.x; asm volatile("" : "+v"(tid));
                    unsigned char* ws = WSP();
                    const int kt = j / 22, nt = j % 22;
                    transpose_tile(IN(I_WIN) + (size_t)1024 * INW, INW, kt * 64, nt * 128, (bf16_t*)(ws + WS_WINT) + (size_t)INWP * 1024, 1024, nullptr, INW - nt * 128, (float*)lds, tid);
                }
            }
        }
    }
}

__device__ __forceinline__ void phase_e(const Params& p, int l, unsigned char* lds, const bool fused) {
    for (int it = blockIdx.x; it < 256; it += gridDim.x) {
        int tid = threadIdx.x; asm volatile("" : "+v"(tid));
        unsigned char* ws = WSP();
        const int w = tid >> 6, lane = tid & 63, wr = w >> 1, wc = w & 1, hf = lane >> 5;
        const int xi_ = it >> 3, m0 = ((it & 7) * 4 + (xi_ >> 3)) * 256, n0 = (xi_ & 7) * 128;
        float* dst = (l == 0) ? (float*)(ws + WS_X1) : OUTP();
        f32x16 acc[2][2];
        const int bidx = m0 < NCTX ? 0 : 1 + ((m0 - NCTX) >> 10);
        const float* gate = (const float*)(ws + WS_MOD) + (size_t)(l * 5 + bidx) * 3072 + 2048;
        const float* xin = (l == 0) ? (m0 < NCTX ? IN(I_XP) : IN(I_XS) - (size_t)NCTX * D) : (const float*)(ws + WS_X1);
        f32x16 xr[2][2];
#pragma unroll
        for (int nt = 0; nt < 2; ++nt)
#pragma unroll
            for (int mt = 0; mt < 2; ++mt)
#pragma unroll
                for (int i = 0; i < 16; ++i)
                    xr[mt][nt][i] = xin[(size_t)(m0 + wr * 64 + mt * 32 + rowmap(i, hf)) * D + n0 + wc * 64 + nt * 32 + (lane & 31)];
        gemm_mainloop<false>((const bf16_t*)(ws + WS_MIXED), 1024, (const bf16_t*)(ws + WS_WOUTT) + (size_t)l * 1024 * 1024, 1024, 1024, m0, n0, lds, acc, tid);
        int tid2 = tid; asm volatile("" : "+v"(tid2));
        const int w2 = tid2 >> 6, lane2 = tid2 & 63, wr2 = w2 >> 1, wc2 = w2 & 1, hf2 = lane2 >> 5;
#pragma unroll
        for (int nt = 0; nt < 2; ++nt) {
            const float gt = gate[n0 + wc2 * 64 + nt * 32 + (lane2 & 31)];
#pragma unroll
            for (int mt = 0; mt < 2; ++mt)
#pragma unroll
                for (int i = 0; i < 16; ++i) acc[mt][nt][i] = xr[mt][nt][i] + gt * acc[mt][nt][i];
        }
        if (!fused) {
#pragma unroll
            for (int nt = 0; nt < 2; ++nt) {
                const int n = n0 + wc2 * 64 + nt * 32 + (lane2 & 31);
#pragma unroll
                for (int mt = 0; mt < 2; ++mt)
#pragma unroll
                    for (int i = 0; i < 16; ++i) dst[(size_t)(m0 + wr2 * 64 + mt * 32 + rowmap(i, hf2)) * D + n] = acc[mt][nt][i];
            }
        } else {
            const int mtile = m0 >> 8, ntile = n0 >> 7;
            {
                float v[32];
#pragma unroll
                for (int mt = 0; mt < 2; ++mt)
#pragma unroll
                    for (int i = 0; i < 16; ++i) v[mt * 16 + i] = acc[mt][0][i] * acc[mt][0][i] + acc[mt][1][i] * acc[mt][1][i];
                const float tot = half_reduce32(v, lane2);
                const int j = lane2 & 31;
                ((float*)lds)[(wr2 * 64 + (j >> 4) * 32 + rowmap(j & 15, hf2)) * 2 + wc2] = tot;
            }
            __syncthreads();
            float* ssf = (float*)(ws + WS_SSF) + (size_t)(l * 32 + mtile) * 8 * 256;
            if (tid2 < 256) ssf[ntile * 256 + tid2] = ((const float*)lds)[2 * tid2] + ((const float*)lds)[2 * tid2 + 1];
            asm volatile("s_waitcnt vmcnt(0)" ::: "memory");
            __syncthreads();
            if (tid2 == 0) {
                unsigned* cnt = (unsigned*)(ws + WS_BAR) + XCHG_CNT + (l * 32 + mtile) * 8;
                __builtin_amdgcn_fence(__ATOMIC_RELEASE, "agent");
                asm volatile("s_waitcnt vmcnt(0)" ::: "memory");
                (void)xb_add(cnt, 1u);
                unsigned sp = 0u;
                while (xb_ld(cnt) < 8u) { __builtin_amdgcn_s_sleep(1); if (++sp > (1u << 22)) break; }
                __builtin_amdgcn_fence(__ATOMIC_ACQUIRE, "agent");
                asm volatile("s_waitcnt vmcnt(0)" ::: "memory");
            }
            __syncthreads();
            float* rsx = (float*)(lds + 4096);
            if (tid2 < 256) {
                float sacc = 0.f;
#pragma unroll
                for (int q = 0; q < 8; ++q) sacc += ssf[q * 256 + tid2];
                rsx[tid2] = rsqrtf(sacc * (1.f / 1024.f) + EPS);
            }
            __syncthreads();
            if (l == 0) {
                float* x1 = (float*)(ws + WS_X1);
                bf16_t* hn = (bf16_t*)(ws + WS_H);
                const float* mod1 = (const float*)(ws + WS_MOD) + (size_t)(5 + bidx) * 3072;
                const float* g1 = IN(I_GNORM) + D;
#pragma unroll
                for (int nt = 0; nt < 2; ++nt) {
                    const int n = n0 + wc2 * 64 + nt * 32 + (lane2 & 31);
                    const float a1 = g1[n] * (1.f + mod1[1024 + n]), sh1 = mod1[n];
#pragma unroll
                    for (int mt = 0; mt < 2; ++mt)
#pragma unroll
                        for (int i = 0; i < 16; ++i) {
                            const int r = wr2 * 64 + mt * 32 + rowmap(i, hf2);
                            const size_t o = (size_t)(m0 + r) * D + n;
                            const float x = acc[mt][nt][i];
                            __hip_atomic_store(&x1[o], x, __ATOMIC_RELAXED, __HIP_MEMORY_SCOPE_AGENT);
                            __hip_atomic_store(&hn[o], f2bf(x * rsx[r] * a1 + sh1), __ATOMIC_RELAXED, __HIP_MEMORY_SCOPE_AGENT);
                        }
                }
            } else {
                float* y = OUTP();
                const float* gf = IN(I_GFINAL);
#pragma unroll
                for (int nt = 0; nt < 2; ++nt) {
                    const int n = n0 + wc2 * 64 + nt * 32 + (lane2 & 31);
                    const float gfn = gf[n];
#pragma unroll
                    for (int mt = 0; mt < 2; ++mt)
#pragma unroll
                        for (int i = 0; i < 16; ++i) {
                            const int r = wr2 * 64 + mt * 32 + rowmap(i, hf2);
                            __builtin_nontemporal_store(acc[mt][nt][i] * rsx[r] * gfn, &y[(size_t)(m0 + r) * D + n]);
                        }
                }
            }
            __syncthreads();
        }
    }
}

__device__ __forceinline__ void phase_f(const Params& p, unsigned char* lds) {
    for (int it = blockIdx.x; it < 1024; it += gridDim.x) {
        int tid = threadIdx.x; asm volatile("" : "+v"(tid));
        const int w = tid >> 6, lane = tid & 63;
        const float* g = IN(I_GFINAL);
        float* x = OUTP() + (size_t)(it * 8 + w) * D;
        f32x4 v[4]; float ss = 0.f;
#pragma unroll
        for (int j = 0; j < 4; ++j) { v[j] = *(const f32x4*)(x + (lane + 64 * j) * 4); ss += v[j][0] * v[j][0] + v[j][1] * v[j][1] + v[j][2] * v[j][2] + v[j][3] * v[j][3]; }
#pragma unroll
        for (int o = 32; o >= 1; o >>= 1) ss += __shfl_xor(ss, o);
        const float rstd = rsqrtf(ss * (1.f / 1024.f) + EPS);
#pragma unroll
        for (int j = 0; j < 4; ++j) {
            const int k = (lane + 64 * j) * 4;
            const f32x4 gg = *(const f32x4*)(g + k);
            f32x4 o; o[0] = v[j][0] * rstd * gg[0]; o[1] = v[j][1] * rstd * gg[1]; o[2] = v[j][2] * rstd * gg[2]; o[3] = v[j][3] * rstd * gg[3];
            *(f32x4*)(x + k) = o;
        }
    }
}

constexpr int N_PHASES = 12;
#ifndef PHASE_MASK
#define PHASE_MASK 0xfff
#endif
__global__ void __launch_bounds__(NT) fwd_kernel(Params p) {
    __shared__ __attribute__((aligned(1024))) unsigned char lds[LDS_BYTES];
    if (p.use_cg) cg::this_grid().sync();
    if (threadIdx.x == 0) {
        volatile LAS unsigned long long* t = (volatile LAS unsigned long long*)(LAS unsigned char*)(lds + LDS_PTR);
#pragma unroll
        for (int i = 0; i < N_IN; ++i) t[i] = (unsigned long long)p.in[i];
        t[N_IN] = (unsigned long long)p.out; t[N_IN + 1] = (unsigned long long)p.ws;
    }
    __syncthreads();
    XcdBarrier xb;
    const bool multi = p.ph_hi > p.ph_lo;
    if (multi) {
        if (threadIdx.x == 0) { *(volatile LAS unsigned*)(LAS unsigned char*)(lds + LDS_XB) = 0u; *(volatile LAS unsigned*)(LAS unsigned char*)(lds + LDS_XB + 4) = 0u; }
        __syncthreads();
        xb = xcd_barrier_post((unsigned*)(p.ws + WS_BAR), (volatile LAS unsigned*)(LAS unsigned char*)(lds + LDS_XB));
    }
    const bool fused = multi && (gridDim.x == 256);
    const int lo = p.ph_lo, hi = fused ? 10 : p.ph_hi;
#ifndef REP_MASK
#define REP_MASK 0
#endif
#define RUN_PHASE(k, call) do { if ((PHASE_MASK & (1 << (k))) && lo <= (k) && (k) <= hi) { call; if (REP_MASK & (1 << (k))) { __syncthreads(); call; } if ((k) < hi) xcd_barrier(xb); } } while (0)
#define RUN_PHASE_NB(k, call) do { if ((PHASE_MASK & (1 << (k))) && lo <= (k) && (k) <= hi) { call; } } while (0)
    RUN_PHASE_NB(0, phase_p0(p, lds));
    RUN_PHASE(1, phase_a(p, 0, lds));
    RUN_PHASE_NB(2, phase_b(p, 0, lds));
    RUN_PHASE(3, phase_c(p, 0, lds));
    RUN_PHASE(4, phase_d(p, 0, lds));
    RUN_PHASE(5, phase_e(p, 0, lds, fused));
    if (!fused) RUN_PHASE(6, phase_a(p, 1, lds));
    RUN_PHASE_NB(7, phase_b(p, 1, lds));
    RUN_PHASE(8, phase_c(p, 1, lds));
    RUN_PHASE(9, phase_d(p, 1, lds));
    RUN_PHASE(10, phase_e(p, 1, lds, fused));
    RUN_PHASE(11, phase_f(p, lds));
#undef RUN_PHASE
}

extern "C" void kernel_launch(void* const* d_in, const int* in_sizes, int n_in, void* d_out, int out_size, void* d_ws, size_t ws_size, hipStream_t stream) {
    static int grid = 0;
    if (grid == 0) {
        int dev = 0, cus = 0, per_cu = 0;
        hipGetDevice(&dev);
        hipDeviceGetAttribute(&cus, hipDeviceAttributeMultiprocessorCount, dev);
        hipOccupancyMaxActiveBlocksPerMultiprocessor(&per_cu, (const void*)fwd_kernel, NT, 0);
        if (per_cu > 1) per_cu = 1;
        if (per_cu < 1) per_cu = 1;
        grid = cus * per_cu;
        if (n_in != N_IN || ws_size < WS_END) { fprintf(stderr, "kernel_launch: unexpected n_in %d / ws_size %zu\n", n_in, ws_size); }
    }
    Params p{};
    for (int i = 0; i < N_IN; ++i) p.in[i] = (const float*)d_in[i];
    p.out = (float*)d_out; p.ws = (unsigned char*)d_ws; p.use_cg = 0; p.pad = 0;
#if MK_MULTI
    for (int ph = 0; ph < N_PHASES; ++ph) {
        p.ph_lo = ph; p.ph_hi = ph;
        hipLaunchKernelGGL(fwd_kernel, dim3(grid), dim3(NT), 0, stream, p);
    }
#else
    hipMemsetAsync((unsigned char*)d_ws + WS_BAR, 0, 16384, stream);
    p.ph_lo = 0; p.ph_hi = N_PHASES - 1;
    void* args[] = {&p};
    hipError_t e = hipLaunchCooperativeKernel((const void*)fwd_kernel, dim3(grid), dim3(NT), args, 0, stream);
    if (e != hipSuccess) fprintf(stderr, "cooperative launch failed: %s (grid %d)\n", hipGetErrorString(e), grid);
#endif
}
```
